# Optimizing an MI355X kernel written in HIP

```python
import math
import jax, jax.numpy as jnp
from jax import lax
import numpy as np

D_MODEL = 1024
BATCH = 8
SEQ = 8192
DEPTH = 2
DEC_BATCH = 16
DEC_SEQ = 16
PAST_LEN = 4096

CHUNK = 64
N_MIXERS = 2
N_S5 = (DEPTH + 1) // 2
N_GDN = DEPTH // 2
EPS = 1e-6

S5_WIDTH = D_MODEL
S5_GROUP = 16
S5_GROUPS = S5_WIDTH // S5_GROUP
S5_STATE = 64

GDN_DK = 128
GDN_DV = 128
GDN_QK_HEADS = D_MODEL // 256
GDN_V_HEADS = 2 * GDN_QK_HEADS
GDN_QK_WIDTH = GDN_QK_HEADS * GDN_DK
GDN_V_WIDTH = GDN_V_HEADS * GDN_DV
GDN_CONV = 4
GDN_CONV_CH = 2 * GDN_QK_WIDTH + GDN_V_WIDTH
GDN_IN = GDN_CONV_CH + GDN_V_WIDTH + 2 * GDN_V_HEADS

kernel_name = "s5_gdn_hybrid_stream_step"

F32 = jnp.float32


def rms_norm(x, g):
    xf = x.astype(F32)
    y = xf * lax.rsqrt(jnp.mean(xf * xf, axis=-1, keepdims=True) + EPS)
    return (y * g.astype(F32)).astype(x.dtype)


def l2norm(x):
    return x * lax.rsqrt(jnp.sum(x * x, axis=-1, keepdims=True) + EPS)


def s5_discretize(log_step, lam_re, lam_im, b_re, b_im):
    step = jnp.exp(log_step.astype(F32))[:, None]
    lr, li = lam_re.astype(F32), lam_im.astype(F32)
    mag = jnp.exp(lr * step)
    ar, ai = mag * jnp.cos(li * step), mag * jnp.sin(li * step)
    den = lr * lr + li * li
    xr = ar - 1.0
    nr = (xr * lr + ai * li) / den
    ni = (ai * lr - xr * li) / den
    br, bi = b_re.astype(F32), b_im.astype(F32)
    bbr = nr[..., None] * br - ni[..., None] * bi
    bbi = nr[..., None] * bi + ni[..., None] * br
    return ar, ai, bbr, bbi


def _cplx_combine(e1, e2):
    a1r, a1i, b1r, b1i = e1
    a2r, a2i, b2r, b2i = e2
    return (a2r * a1r - a2i * a1i, a2r * a1i + a2i * a1r,
            a2r * b1r - a2i * b1i + b2r, a2r * b1i + a2i * b1r + b2i)


def s5_scan(u, h_re, h_im, ar, ai, bbr, bbi, c_re, c_im):
    bsz, L, E = u.shape
    T = CHUNK if L % CHUNK == 0 else L
    n = L // T
    ug = u.reshape(bsz, n, T, S5_GROUPS, S5_GROUP).transpose(1, 0, 2, 3, 4)
    a_r = jnp.broadcast_to(ar[None, None], (bsz, T, S5_GROUPS, S5_STATE))
    a_i = jnp.broadcast_to(ai[None, None], (bsz, T, S5_GROUPS, S5_STATE))

    def step(carry, uc):
        hr, hi = carry
        br = jnp.einsum('gpc,btgc->btgp', bbr, uc)
        bi = jnp.einsum('gpc,btgc->btgp', bbi, uc)
        pr, pi, sr, si = lax.associative_scan(_cplx_combine, (a_r, a_i, br, bi), axis=1)
        xr = pr * hr[:, None] - pi * hi[:, None] + sr
        xi = pr * hi[:, None] + pi * hr[:, None] + si
        y = jnp.einsum('gcp,btgp->btgc', c_re, xr) - jnp.einsum('gcp,btgp->btgc', c_im, xi)
        return (xr[:, -1], xi[:, -1]), y

    (hr, hi), ys = lax.scan(step, (h_re, h_im), ug)
    y = ys.transpose(1, 0, 2, 3, 4).reshape(bsz, L, E)
    return y, hr, hi


def s5_branch(h, h_re, h_im, w_in, log_step, lam_re, lam_im, b_re, b_im,
              c_re, c_im, d, w_glu, b_glu, w_out):
    proj = h @ w_in
    u, z = jnp.split(proj, 2, axis=-1)
    uf = u.astype(F32)
    ar, ai, bbr, bbi = s5_discretize(log_step, lam_re, lam_im, b_re, b_im)
    y, hr, hi = s5_scan(uf, h_re.astype(F32), h_im.astype(F32), ar, ai, bbr, bbi,
                        c_re.astype(F32), c_im.astype(F32))
    y = jax.nn.gelu(y + d.astype(F32) * uf)
    y = y * jax.nn.sigmoid(y @ w_glu.astype(F32) + b_glu.astype(F32))
    y = y * jax.nn.silu(z.astype(F32))
    return y.astype(h.dtype) @ w_out, hr, hi


def gated_delta_rule(q, k, v, beta, g, S0):
    bsz, L, H, _ = q.shape
    T = CHUNK if L % CHUNK == 0 else L
    n = L // T

    def chunks(t):
        t = t.reshape((bsz, n, T, H) + t.shape[3:])
        return jnp.moveaxis(t, (1, 3), (0, 2))

    causal = jnp.tril(jnp.ones((T, T), bool))
    strict = jnp.tril(jnp.ones((T, T), bool), -1)
    eye = jnp.eye(T, dtype=F32)

    def step(S, inp):
        qc, kc, vc, bc, gc = inp
        gcum = jnp.cumsum(gc, axis=-1)
        decay = jnp.exp(jnp.where(causal, gcum[..., :, None] - gcum[..., None, :], -jnp.inf))
        kb = kc * bc[..., None]
        m = jnp.where(strict, jnp.einsum('bhik,bhjk->bhij', kb, kc) * decay, 0.0)
        rhs = jnp.concatenate([vc * bc[..., None], kb * jnp.exp(gcum)[..., None]], axis=-1)
        sol = lax.linalg.triangular_solve(eye + m, rhs, left_side=True, lower=True,
                                          unit_diagonal=True)
        u, w = sol[..., :GDN_DV], sol[..., GDN_DV:]
        v_new = u - jnp.einsum('bhtk,bhkv->bhtv', w, S)
        qk = jnp.einsum('bhik,bhjk->bhij', qc, kc) * decay
        o = (jnp.einsum('bhtk,bhkv->bhtv', qc * jnp.exp(gcum)[..., None], S)
             + jnp.einsum('bhij,bhjv->bhiv', qk, v_new))
        g_last = gcum[..., -1]
        S_new = (S * jnp.exp(g_last)[..., None, None]
                 + jnp.einsum('bhtk,bhtv->bhkv',
                              kc * jnp.exp(g_last[..., None] - gcum)[..., None], v_new))
        return S_new, o

    S, os_ = lax.scan(step, S0, (chunks(q), chunks(k), chunks(v), chunks(beta), chunks(g)))
    o = jnp.moveaxis(os_, (0, 2), (1, 3)).reshape(bsz, L, H, GDN_DV)
    return o, S


def gdn_branch(h, conv_hist, S0, w_in, conv_w, a_log, dt_bias, norm_g, w_out):
    bsz, L, _ = h.shape
    proj = h @ w_in
    o1 = GDN_CONV_CH
    o2 = o1 + GDN_V_WIDTH
    o3 = o2 + GDN_V_HEADS
    qkv, z, b_raw, a_raw = proj[..., :o1], proj[..., o1:o2], proj[..., o2:o3], proj[..., o3:]
    full = jnp.concatenate([conv_hist.astype(qkv.dtype), qkv], axis=1)
    conv = full[:, 0:L] * conv_w[0]
    for j in range(1, GDN_CONV):
        conv = conv + full[:, j:j + L] * conv_w[j]
    new_hist = full[:, L:]
    act = jax.nn.silu(conv.astype(F32))
    q = act[..., :GDN_QK_WIDTH].reshape(bsz, L, GDN_QK_HEADS, GDN_DK)
    k = act[..., GDN_QK_WIDTH:2 * GDN_QK_WIDTH].reshape(bsz, L, GDN_QK_HEADS, GDN_DK)
    v = act[..., 2 * GDN_QK_WIDTH:].reshape(bsz, L, GDN_V_HEADS, GDN_DV)
    rep = GDN_V_HEADS // GDN_QK_HEADS
    q = jnp.repeat(l2norm(q) * (GDN_DK ** -0.5), rep, axis=2)
    k = jnp.repeat(l2norm(k), rep, axis=2)
    beta = jax.nn.sigmoid(b_raw.astype(F32))
    g = -jnp.exp(a_log.astype(F32)) * jax.nn.softplus(a_raw.astype(F32) + dt_bias.astype(F32))
    o, S = gated_delta_rule(q, k, v, beta, g, S0.astype(F32))
    o = rms_norm(o, norm_g) * jax.nn.silu(z.astype(F32).reshape(bsz, L, GDN_V_HEADS, GDN_DV))
    out = o.reshape(bsz, L, GDN_V_WIDTH).astype(h.dtype) @ w_out
    return out, new_hist, S


def trunk(x, c, s5_re0, s5_im0, gdn_s0, gdn_conv0, weights):
    (norm_g, w_ada, b_ada, s5_w_in, s5_log_step, s5_lambda_re, s5_lambda_im, s5_b_re, s5_b_im,
     s5_c_re, s5_c_im, s5_d, s5_w_glu, s5_b_glu, s5_w_out, gdn_w_in, gdn_conv_w, gdn_a_log,
     gdn_dt_bias, gdn_norm_g, gdn_w_out, final_g) = weights
    s5_re_out, s5_im_out, gdn_s_out, gdn_conv_out = [], [], [], []
    cs = jax.nn.silu(c)
    for i in range(DEPTH):
        j = i // N_MIXERS
        mod = cs @ w_ada[i] + b_ada[i]
        shift, scale, gate = jnp.split(mod[:, None, :], 3, axis=-1)
        h = rms_norm(x, norm_g[i]) * (1.0 + scale) + shift
        if i % N_MIXERS == 0:
            out, hr, hi = s5_branch(h, s5_re0[j], s5_im0[j], s5_w_in[j], s5_log_step[j],
                                    s5_lambda_re[j], s5_lambda_im[j], s5_b_re[j], s5_b_im[j],
                                    s5_c_re[j], s5_c_im[j], s5_d[j], s5_w_glu[j], s5_b_glu[j],
                                    s5_w_out[j])
            s5_re_out.append(hr)
            s5_im_out.append(hi)
        else:
            out, hist, S = gdn_branch(h, gdn_conv0[j], gdn_s0[j], gdn_w_in[j], gdn_conv_w[j],
                                      gdn_a_log[j], gdn_dt_bias[j], gdn_norm_g[j], gdn_w_out[j])
            gdn_conv_out.append(hist)
            gdn_s_out.append(S)
        x = x + gate * out
    y = rms_norm(x, final_g)
    return (y, jnp.stack(s5_re_out), jnp.stack(s5_im_out), jnp.stack(gdn_s_out),
            jnp.stack(gdn_conv_out))


def setup_inputs(seed: int = 0) -> dict:
    key = jax.random.key(seed)
    ks = iter(jax.random.split(key, 40))

    def nrm(shape, s):
        return jax.random.normal(next(ks), shape, F32) * s

    def unif(shape, lo, hi):
        return jax.random.uniform(next(ks), shape, F32, minval=lo, maxval=hi)

    D, E, G, P = D_MODEL, S5_WIDTH, S5_GROUPS, S5_STATE
    lam_im = jnp.broadcast_to(jnp.pi * jnp.arange(P, dtype=F32), (N_S5, G, P))
    dt = jnp.exp(unif((N_GDN, GDN_V_HEADS), math.log(1e-3), math.log(1e-1)))
    return {
        "x_prompt": nrm((BATCH, SEQ, D), 1.0),
        "x_sample": nrm((DEC_BATCH, DEC_SEQ, D), 1.0),
        "c_prompt": nrm((BATCH, D), 1.0),
        "c_sample": nrm((DEC_BATCH, D), 1.0),
        "state_s5_re": nrm((N_S5, DEC_BATCH, G, P), 0.1),
        "state_s5_im": nrm((N_S5, DEC_BATCH, G, P), 0.1),
        "state_gdn": nrm((N_GDN, DEC_BATCH, GDN_V_HEADS, GDN_DK, GDN_DV), 0.1),
        "state_gdn_conv": nrm((N_GDN, DEC_BATCH, GDN_CONV - 1, GDN_CONV_CH), 1.0),
        "norm_g": 1.0 + nrm((DEPTH, D), 0.02),
        "w_ada": nrm((DEPTH, D, 3 * D), 0.5 * D ** -0.5),
        "b_ada": nrm((DEPTH, 3 * D), 0.02),
        "s5_w_in": nrm((N_S5, D, 2 * E), D ** -0.5),
        "s5_log_step": unif((N_S5, G), math.log(1e-3), math.log(1e-1)),
        "s5_lambda_re": -0.5 + nrm((N_S5, G, P), 0.01),
        "s5_lambda_im": lam_im + nrm((N_S5, G, P), 0.01),
        "s5_b_re": nrm((N_S5, G, P, S5_GROUP), (2 * S5_GROUP) ** -0.5),
        "s5_b_im": nrm((N_S5, G, P, S5_GROUP), (2 * S5_GROUP) ** -0.5),
        "s5_c_re": nrm((N_S5, G, S5_GROUP, P), 0.5),
        "s5_c_im": nrm((N_S5, G, S5_GROUP, P), 0.5),
        "s5_d": nrm((N_S5, E), 1.0),
        "s5_w_glu": nrm((N_S5, E, E), E ** -0.5),
        "s5_b_glu": nrm((N_S5, E), 0.02),
        "s5_w_out": nrm((N_S5, E, D), E ** -0.5),
        "gdn_w_in": nrm((N_GDN, D, GDN_IN), D ** -0.5),
        "gdn_conv_w": nrm((N_GDN, GDN_CONV, GDN_CONV_CH), 0.5),
        "gdn_a_log": jnp.log(unif((N_GDN, GDN_V_HEADS), 1.0, 16.0)),
        "gdn_dt_bias": dt + jnp.log(-jnp.expm1(-dt)),
        "gdn_norm_g": 1.0 + nrm((N_GDN, GDN_DV), 0.02),
        "gdn_w_out": nrm((N_GDN, GDN_V_WIDTH, D), GDN_V_WIDTH ** -0.5),
        "final_g": 1.0 + nrm((D,), 0.02),
    }


def reference(x_prompt, x_sample, c_prompt, c_sample, state_s5_re, state_s5_im, state_gdn,
              state_gdn_conv, norm_g, w_ada, b_ada, s5_w_in, s5_log_step, s5_lambda_re,
              s5_lambda_im, s5_b_re, s5_b_im, s5_c_re, s5_c_im, s5_d, s5_w_glu, s5_b_glu,
              s5_w_out, gdn_w_in, gdn_conv_w, gdn_a_log, gdn_dt_bias, gdn_norm_g, gdn_w_out,
              final_g):
    weights = (norm_g, w_ada, b_ada, s5_w_in, s5_log_step, s5_lambda_re, s5_lambda_im, s5_b_re,
               s5_b_im, s5_c_re, s5_c_im, s5_d, s5_w_glu, s5_b_glu, s5_w_out, gdn_w_in,
               gdn_conv_w, gdn_a_log, gdn_dt_bias, gdn_norm_g, gdn_w_out, final_g)
    bp = x_prompt.shape[0]
    z_s5 = jnp.zeros((N_S5, bp, S5_GROUPS, S5_STATE), F32)
    z_gdn = jnp.zeros((N_GDN, bp, GDN_V_HEADS, GDN_DK, GDN_DV), F32)
    z_conv = jnp.zeros((N_GDN, bp, GDN_CONV - 1, GDN_CONV_CH), x_prompt.dtype)
    y_prompt, s5r_p, s5i_p, gdn_p, conv_p = trunk(x_prompt, c_prompt, z_s5, z_s5, z_gdn,
                                                  z_conv, weights)
    y_sample, s5r_s, s5i_s, gdn_s, conv_s = trunk(x_sample, c_sample, state_s5_re, state_s5_im,
                                                  state_gdn, state_gdn_conv, weights)
    return (y_prompt, y_sample, s5r_p, s5i_p, gdn_p, conv_p, s5r_s, s5i_s, gdn_s, conv_s)
```

```cpp
#include <hip/hip_runtime.h>
#include <hip/hip_cooperative_groups.h>
#include <cstdio>
namespace cg = cooperative_groups;

typedef unsigned short bf16_t;
typedef short bf16x8 __attribute__((ext_vector_type(8)));
typedef float f32x4 __attribute__((ext_vector_type(4)));
#define DI __device__ __forceinline__

constexpr int D = 1024;
constexpr int MP = 65536;
constexpr int MS = 256;
constexpr int M = MP + MS;
constexpr int NCH = 1040;
constexpr float EPS = 1e-6f;
constexpr int LDS_BYTES = 128 * 1024 + 2048;
#define REP_SETUP 1
#define REP_GEMM 1
#define REP_S5 1
#define REP_PREP 1
#define REP_SEQ 1

constexpr size_t O_Y = 0;
constexpr size_t O_S5RE_P = 67371008;
constexpr size_t O_S5IM_P = 67403776;
constexpr size_t O_GDN_P = 67436544;
constexpr size_t O_CONV_P = 68485120;
constexpr size_t O_S5RE_S = 68534272;
constexpr size_t O_S5IM_S = 68599808;
constexpr size_t O_GDN_S = 68665344;
constexpr size_t O_CONV_S = 70762496;

constexpr size_t MU = (size_t)M * 1024 * 2;
constexpr size_t W_S5IN = 0;
constexpr size_t W_GLU = 4194304;
constexpr size_t W_S5OUT = 6291456;
constexpr size_t W_GDNIN = 8388608;
constexpr size_t W_GDNOUT = 15204352;
constexpr size_t W_MOD = 17301504;
constexpr size_t W_BA = 17891328;
constexpr size_t W_USAMP = 22102016;
constexpr size_t W_ABAR = 23150592;
constexpr size_t W_A64 = 23183360;
constexpr size_t W_BBAR = 23216128;
constexpr size_t W_ZERO = 23740416;
constexpr size_t W_BAR = 23740672;
constexpr size_t W_SLOT0 = 25165824;
constexpr size_t W_SLOT1 = W_SLOT0 + MU;
constexpr size_t W_SLOT2 = W_SLOT1 + MU;
constexpr size_t W_SLOT3 = W_SLOT2 + MU;
constexpr size_t W_X = W_SLOT3 + MU;
constexpr size_t W_KTAB = W_X;
constexpr size_t W_ME = W_KTAB + 2097152;
constexpr size_t W_MC = W_ME + 16777216;
constexpr size_t W_E = W_MC + 16777216;
constexpr size_t W_H = W_E + 67108864;
constexpr size_t W_GW = W_X;
constexpr size_t W_GU = W_GW + (size_t)NCH * 8 * 64 * 128 * 2;
constexpr size_t W_GQK = W_GU + (size_t)NCH * 8 * 64 * 128 * 2;
constexpr size_t W_GQ = W_GQK + (size_t)NCH * 8 * 64 * 64 * 2;
constexpr size_t W_GKT = W_GQ + (size_t)NCH * 4 * 64 * 128 * 2;
constexpr size_t W_GGC = W_GKT + (size_t)NCH * 4 * 64 * 128 * 2;

struct Params {
  const float* x_prompt; const float* x_sample; const float* c_prompt; const float* c_sample;
  const float* st_s5_re; const float* st_s5_im; const float* st_gdn; const float* st_conv;
  const float* norm_g; const float* w_ada; const float* b_ada; const float* s5_w_in;
  const float* s5_log_step; const float* s5_lam_re; const float* s5_lam_im; const float* s5_b_re;
  const float* s5_b_im; const float* s5_c_re; const float* s5_c_im; const float* s5_d;
  const float* s5_w_glu; const float* s5_b_glu; const float* s5_w_out; const float* gdn_w_in;
  const float* gdn_conv_w; const float* gdn_a_log; const float* gdn_dt_bias; const float* gdn_norm_g;
  const float* gdn_w_out; const float* final_g;
  float* out; char* ws;
};

DI int otid() { int t = threadIdx.x; asm volatile("" : "+v"(t)); return t; }
#define VTID (otid() & 255)
#define VBID ((int)(blockIdx.x * 2 + (otid() >> 8)))
#define VGRID ((int)(gridDim.x * 2))
typedef __bf16 hwbf16x2 __attribute__((ext_vector_type(2)));
typedef float hwf32x2 __attribute__((ext_vector_type(2)));
DI bf16_t f2bf(float f) { const __bf16 r = (__bf16)f; return __builtin_bit_cast(bf16_t, r); }
DI float bf2f(bf16_t h) { return __uint_as_float(((unsigned)h) << 16); }
DI unsigned pack2(float a, float b) { const hwf32x2 v = {a, b}; const hwbf16x2 r = __builtin_convertvector(v, hwbf16x2); return __builtin_bit_cast(unsigned, r); }
DI float sigmoidf_(float x) { return __builtin_amdgcn_rcpf(1.0f + __expf(-x)); }
DI float siluf_(float x) { return x * sigmoidf_(x); }
DI float geluf_(float x) { return x * sigmoidf_(1.5957691216057308f * (x + 0.044715f * x * x * x)); }
DI float wave_sum(float v) {
#pragma unroll
  for (int o = 32; o >= 1; o >>= 1) v += __shfl_xor(v, o);
  return v;
}
DI float4 ldnt4(const float* p) { const f32x4 v = __builtin_nontemporal_load((const f32x4*)p); float4 r; r.x = v[0]; r.y = v[1]; r.z = v[2]; r.w = v[3]; return r; }
DI void stnt4(float* p, float4 o) { f32x4 v; v[0] = o.x; v[1] = o.y; v[2] = o.z; v[3] = o.w; __builtin_nontemporal_store(v, (f32x4*)p); }
DI int row_bi(int r) { return r < MP ? (r >> 13) : 8 + ((r - MP) >> 4); }
DI const float* xrow(const Params& p, int r) { return r < MP ? p.x_prompt + (size_t)r * D : p.x_sample + (size_t)(r - MP) * D; }
DI bf16x8 mkfrag(f32x4 a, f32x4 b) {
  typedef unsigned u32x4 __attribute__((ext_vector_type(4)));
  u32x4 v; v[0] = pack2(a[0], a[1]); v[1] = pack2(a[2], a[3]); v[2] = pack2(b[0], b[1]); v[3] = pack2(b[2], b[3]);
  return __builtin_bit_cast(bf16x8, v);
}
DI void lds_barrier() { asm volatile("s_waitcnt lgkmcnt(0)" ::: "memory"); __builtin_amdgcn_s_barrier(); asm volatile("" ::: "memory"); }
#define MFMA16(a, b, c) __builtin_amdgcn_mfma_f32_16x16x32_bf16((a), (b), (c), 0, 0, 0)

DI bf16x8 ldfrag(const char* base, int rowbytes, int row, int chunk) {
  return *(const bf16x8*)(base + row * rowbytes + ((chunk ^ (row & 7)) << 4));
}
DI bf16x8 ldfrag_perm(const char* base, int rowbytes, int row, int c, int fq) {
  typedef unsigned u32x2 __attribute__((ext_vector_type(2)));
  typedef unsigned u32x4 __attribute__((ext_vector_type(4)));
  const int ch0 = 4 * c + (fq >> 1), ch1 = ch0 + 2, off = (fq & 1) * 8;
  const u32x2 lo = *(const u32x2*)(base + row * rowbytes + ((ch0 ^ (row & 7)) << 4) + off);
  const u32x2 hi = *(const u32x2*)(base + row * rowbytes + ((ch1 ^ (row & 7)) << 4) + off);
  u32x4 v; v[0] = lo[0]; v[1] = lo[1]; v[2] = hi[0]; v[3] = hi[1];
  return __builtin_bit_cast(bf16x8, v);
}

DI int kperm(int k) { const int ki = k & 31; return (k & ~31) + ((ki & 15) >> 2) * 8 + (ki >> 4) * 4 + (ki & 3); }
DI int tile_remap(int L, int nt) {
  const int q = nt >> 3, r = nt & 7, xcd = L & 7, off = L >> 3;
  return (xcd < r ? xcd * (q + 1) : r * (q + 1) + (xcd - r) * q) + off;
}

#define LAS __attribute__((address_space(3)))
struct NoLoad {};
struct LdY { uint2 u; float4 d; };
template <class FA, class FB, class FL, class FS>
DI void gemm_tile(char* lds, int ksteps, int rot, FA fa, FB fb, FL fl, FS fs) {
  const int tid = VTID, lane = tid & 63, wave = tid >> 6;
  const int wr = wave >> 1, wc = wave & 1, fr = lane & 15, fq = lane >> 4;
  f32x4 acc[4][4];
#pragma unroll
  for (int m = 0; m < 4; ++m)
#pragma unroll
    for (int n = 0; n < 4; ++n) acc[m][n] = (f32x4){0.f, 0.f, 0.f, 0.f};
  LAS char* l3 = (LAS char*)lds;
#pragma unroll
  for (int i = 0; i < 4; ++i) {
    const int id = tid + i * 256, r = id >> 3, c = (id & 7) ^ (r & 7);
    __builtin_amdgcn_global_load_lds((const unsigned*)fa(r, rot * 8 + c), (LAS unsigned*)(l3 + id * 16), 16, 0, 0);
    __builtin_amdgcn_global_load_lds((const unsigned*)fb(r, rot * 8 + c), (LAS unsigned*)(l3 + 16384 + id * 16), 16, 0, 0);
  }
  asm volatile("s_waitcnt vmcnt(0)" ::: "memory");
  __syncthreads();
  for (int ks = 0; ks < ksteps; ++ks) {
    const int cur = ks & 1;
    if (ks + 1 < ksteps) {
      int kn = ks + 1 + rot; if (kn >= ksteps) kn -= ksteps;
      LAS char* dst = l3 + (cur ^ 1) * 32768;
#pragma unroll
      for (int i = 0; i < 4; ++i) {
        const int id = tid + i * 256, r = id >> 3, c = (id & 7) ^ (r & 7);
        __builtin_amdgcn_global_load_lds((const unsigned*)fa(r, kn * 8 + c), (LAS unsigned*)(dst + id * 16), 16, 0, 0);
        __builtin_amdgcn_global_load_lds((const unsigned*)fb(r, kn * 8 + c), (LAS unsigned*)(dst + 16384 + id * 16), 16, 0, 0);
      }
    }
    const char* A = lds + cur * 32768;
    const char* B = A + 16384;
#pragma unroll
    for (int kk = 0; kk < 2; ++kk) {
      bf16x8 af[4], bq[4];
#pragma unroll
      for (int m = 0; m < 4; ++m) af[m] = ldfrag(A, 128, wr * 64 + m * 16 + fr, kk * 4 + fq);
#pragma unroll
      for (int n = 0; n < 4; ++n) bq[n] = ldfrag(B, 128, wc * 64 + n * 16 + fr, kk * 4 + fq);
#pragma unroll
      for (int m = 0; m < 4; ++m)
#pragma unroll
        for (int n = 0; n < 4; ++n) acc[m][n] = MFMA16(bq[n], af[m], acc[m][n]);
    }
    asm volatile("s_waitcnt vmcnt(0)" ::: "memory");
    __syncthreads();
  }
  decltype(fl(0, 0)) ld[4][4];
#pragma unroll
  for (int m = 0; m < 4; ++m)
#pragma unroll
    for (int n = 0; n < 4; ++n) ld[m][n] = fl(wr * 64 + m * 16 + fr, wc * 64 + n * 16 + 4 * fq);
#pragma unroll
  for (int m = 0; m < 4; ++m)
#pragma unroll
    for (int n = 0; n < 4; ++n) fs(wr * 64 + m * 16 + fr, wc * 64 + n * 16 + 4 * fq, acc[m][n], ld[m][n]);
}
template <class FA, class FB, class FE>
DI void gemm_tile(char* lds, int ksteps, int rot, FA fa, FB fb, FE fe) {
  gemm_tile(lds, ksteps, rot, fa, fb, [](int, int) { return NoLoad{}; }, [&](int r, int c, f32x4 v, const NoLoad&) { fe(r, c, v); });
}

DI int lds_byte8(int r, int c) { const int st = (r >> 4) * 2 + (c >> 5), rr = r & 15, cc = c & 31, ob = rr * 64 + cc * 2; return st * 1024 + (ob ^ (((ob >> 9) & 1) << 5)); }
DI void stage_rc8(int b, int& R, int& C) { const int st = b / 1024, sb = b % 1024, swz = sb ^ (((sb >> 9) & 1) << 5); R = (st >> 1) * 16 + swz / 64; C = (st & 1) * 32 + (swz % 64) / 2; }
struct Ld2 { float4 a, b; };
template <class FL, class FS>
DI void gemm8_tile(char* shmc, const bf16_t* __restrict__ A, const bf16_t* __restrict__ Bt, const int K, const int brow, const int bcol, FL fl, FS fs) {
  constexpr int HT = 8192, HALF = 128;
  bf16_t* shm = (bf16_t*)shmc;
#define SA(b, h) (shm + ((b) * 2 + (h)) * HT)
#define SB(b, h) (shm + (4 + (b) * 2 + (h)) * HT)
#define STAGE(P, BASE, br, kt) do { const long _g = (long)(br) * K + (long)(kt) * 64; \
    _Pragma("unroll") for (int _i = 0; _i < 2; ++_i) { const int _b = tidx * 16 + _i * 8192; int _r, _c; stage_rc8(_b, _r, _c); \
      __builtin_amdgcn_global_load_lds((const unsigned*)(BASE + _g + (long)_r * K + _c), (LAS unsigned*)((LAS char*)(P) + _b), 16, 0, 0); } } while (0)
#define LDA(dst, b, h) _Pragma("unroll") for (int m = 0; m < 4; ++m) _Pragma("unroll") for (int k = 0; k < 2; ++k) \
    dst[m][k] = *reinterpret_cast<const bf16x8*>((const char*)SA(b, h) + lds_byte8(wr * 64 + m * 16 + fr, k * 32 + fq * 8))
#define LDB(dst, b, h) _Pragma("unroll") for (int n = 0; n < 2; ++n) _Pragma("unroll") for (int k = 0; k < 2; ++k) \
    dst[n][k] = *reinterpret_cast<const bf16x8*>((const char*)SB(b, h) + lds_byte8(wc * 32 + n * 16 + fr, k * 32 + fq * 8))
#define MMA(ai, bj, At_, Bt_) do { __builtin_amdgcn_s_setprio(1); \
    _Pragma("unroll") for (int m = 0; m < 4; ++m) _Pragma("unroll") for (int n = 0; n < 2; ++n) _Pragma("unroll") for (int k = 0; k < 2; ++k) \
      acc[ai][bj][m][n] = MFMA16(Bt_[n][k], At_[m][k], acc[ai][bj][m][n]); \
    __builtin_amdgcn_s_setprio(0); } while (0)
#define WAIT_V(n) asm volatile("s_waitcnt vmcnt(" #n ")" ::: "memory")
#define WAIT_L(n) asm volatile("s_waitcnt lgkmcnt(" #n ")" ::: "memory")
#define BAR __builtin_amdgcn_s_barrier()
#define SCHED __builtin_amdgcn_sched_barrier(0)
  const int tidx = otid();
  const int wid = tidx >> 6, lane = tidx & 63, wr = wid >> 2, wc = wid & 3, fr = lane & 15, fq = lane >> 4;
  f32x4 acc[2][2][4][2];
#pragma unroll
  for (int a = 0; a < 2; ++a)
#pragma unroll
    for (int b = 0; b < 2; ++b)
#pragma unroll
      for (int m = 0; m < 4; ++m)
#pragma unroll
        for (int n = 0; n < 2; ++n) acc[a][b][m][n] = (f32x4){0.f, 0.f, 0.f, 0.f};
  bf16x8 At[4][2], B0[2][2], B1[2][2];
  const int nt = K / 64;
  STAGE(SB(0, 0), Bt, bcol, 0); STAGE(SA(0, 0), A, brow, 0);
  STAGE(SB(0, 1), Bt, bcol + HALF, 0); STAGE(SA(0, 1), A, brow + HALF, 0);
  if (wr == 1) BAR;
  WAIT_V(4); BAR;
  STAGE(SB(1, 0), Bt, bcol, 1); STAGE(SA(1, 0), A, brow, 1); STAGE(SB(1, 1), Bt, bcol + HALF, 1);
  WAIT_V(6); BAR;
  for (int t = 0; t < nt - 2; t += 2) {
    LDB(B0, 0, 0); SCHED; LDA(At, 0, 0); STAGE(SA(1, 1), A, brow + HALF, t + 1);
    WAIT_L(8); BAR; WAIT_L(0); MMA(0, 0, At, B0); BAR; SCHED;
    LDB(B1, 0, 1); STAGE(SB(0, 0), Bt, bcol, t + 2);
    BAR; WAIT_L(0); MMA(0, 1, At, B1); BAR;
    LDA(At, 0, 1); STAGE(SA(0, 0), A, brow, t + 2);
    BAR; WAIT_L(0); MMA(1, 0, At, B0); BAR; SCHED;
    STAGE(SB(0, 1), Bt, bcol + HALF, t + 2);
    WAIT_V(6); BAR; MMA(1, 1, At, B1); BAR;
    LDB(B0, 1, 0); SCHED; LDA(At, 1, 0); STAGE(SA(0, 1), A, brow + HALF, t + 2);
    WAIT_L(8); BAR; WAIT_L(0); MMA(0, 0, At, B0); BAR; SCHED;
    LDB(B1, 1, 1); STAGE(SB(1, 0), Bt, bcol, t + 3);
    BAR; WAIT_L(0); MMA(0, 1, At, B1); BAR;
    LDA(At, 1, 1); STAGE(SA(1, 0), A, brow, t + 3);
    BAR; WAIT_L(0); MMA(1, 0, At, B0); BAR; SCHED;
    STAGE(SB(1, 1), Bt, bcol + HALF, t + 3);
    WAIT_V(6); BAR; MMA(1, 1, At, B1); BAR;
  }
  { LDB(B0, 0, 0); LDA(At, 0, 0); STAGE(SA(1, 1), A, brow + HALF, nt - 1);
    BAR; WAIT_L(0); MMA(0, 0, At, B0); BAR;
    LDB(B1, 0, 1); BAR; WAIT_L(0); MMA(0, 1, At, B1); BAR;
    LDA(At, 0, 1); WAIT_V(4); BAR; WAIT_L(0); MMA(1, 0, At, B0); MMA(1, 1, At, B1); BAR; }
  { LDB(B0, 1, 0); LDA(At, 1, 0); WAIT_V(2); BAR; WAIT_L(0); MMA(0, 0, At, B0); BAR;
    LDB(B1, 1, 1); WAIT_V(0); BAR; WAIT_L(0); MMA(0, 1, At, B1); BAR;
    LDA(At, 1, 1); BAR; WAIT_L(0); MMA(1, 0, At, B0); MMA(1, 1, At, B1); BAR; }
  if (wr == 0) BAR;
#pragma unroll
  for (int ai = 0; ai < 2; ++ai)
#pragma unroll
    for (int mh = 0; mh < 2; ++mh) {
      decltype(fl(0, 0)) ld[2][2][2];
#pragma unroll
      for (int mm = 0; mm < 2; ++mm)
#pragma unroll
        for (int bj = 0; bj < 2; ++bj)
#pragma unroll
          for (int n = 0; n < 2; ++n) ld[mm][bj][n] = fl(brow + ai * HALF + wr * 64 + (2 * mh + mm) * 16 + fr, bcol + bj * HALF + wc * 32 + n * 16 + 4 * fq);
#pragma unroll
      for (int mm = 0; mm < 2; ++mm)
#pragma unroll
        for (int bj = 0; bj < 2; ++bj)
#pragma unroll
          for (int n = 0; n < 2; ++n) fs(brow + ai * HALF + wr * 64 + (2 * mh + mm) * 16 + fr, bcol + bj * HALF + wc * 32 + n * 16 + 4 * fq, acc[ai][bj][2 * mh + mm][n], ld[mm][bj][n]);
    }
  asm volatile("s_waitcnt vmcnt(0)" ::: "memory");
  __syncthreads();
#undef SA
#undef SB
#undef STAGE
#undef LDA
#undef LDB
#undef MMA
}
DI void tile8_order(int L, int nM, int nN, int& pm, int& pn) {
  const int t = tile_remap(L, nM * nN), nig = 8 * nN, gid = t / nig, fm = gid * 8, gsz = (nM - fm) < 8 ? (nM - fm) : 8;
  pm = fm + ((t % nig) % gsz); pn = (t % nig) / gsz;
}

DI void st_bf4(bf16_t* p, float a, float b, float c, float d) { uint2 v; v.x = pack2(a, b); v.y = pack2(c, d); *(uint2*)p = v; }
DI void ld_bf4(const bf16_t* p, float& a, float& b, float& c, float& d) {
  const uint2 v = *(const uint2*)p; a = __uint_as_float(v.x << 16); b = __uint_as_float(v.x & 0xffff0000u); c = __uint_as_float(v.y << 16); d = __uint_as_float(v.y & 0xffff0000u);
}

struct Sub { int vb, vg; bool samp; };
template <class FL, class FS>
DI void gemm_dispatch(const Sub& s, char* lds_all, const bf16_t* A, const bf16_t* Bt, const int nN256, FL fl, FS fs) {
  if (!s.samp) {
    const int nM = 256;
    for (int L = blockIdx.x; L < nM * nN256; L += gridDim.x) {
      int pm, pn; tile8_order(L, nM, nN256, pm, pn);
      gemm8_tile(lds_all, A, Bt, D, pm * 256, pn * 256, fl, fs);
    }
  } else {
    char* ldsh = lds_all + ((otid() >> 8) << 16);
    const int nN = nN256 * 2, nt = 2 * nN;
    for (int k_ = 0; k_ * s.vg < nt; ++k_) {
      int t = k_ * s.vg + s.vb;
      if (k_ * s.vg + (s.vb & ~1) >= nt) continue;
      if (t >= nt) t = nt - 1;
      const int row0 = MP + (t / nN) * 128, col0 = (t % nN) * 128;
      gemm_tile(ldsh, 16, 0,
        [&](int r, int kc) { return A + (size_t)(row0 + r) * D + kc * 8; },
        [&](int n, int kc) { return Bt + (size_t)(col0 + n) * D + kc * 8; },
        [&](int r, int c, f32x4 v) { fs(row0 + r, col0 + c, v, fl(row0 + r, col0 + c)); });
    }
  }
}

DI void phase_setup(const Params& p, char* lds) {
  const int tid = VTID;
  if (VBID == 0 && tid < 16) ((unsigned*)(p.ws + W_ZERO))[tid] = 0u;
  const int NITEM = 384 + 2112 + 256;
  for (int k_ = 0; k_ * VGRID < (NITEM); ++k_) {
    int it = k_ * VGRID + VBID; const bool active_ = it < (NITEM); if (!active_) it = (NITEM) - 1;
    if (it < 384) {
      const int layer = it / 192, cc = it % 192, col = tid & 15, kp = tid >> 4;
      float* cs = (float*)lds;
      float acc[24];
#pragma unroll
      for (int i = 0; i < 24; ++i) acc[i] = 0.f;
      for (int kh = 0; kh < 2; ++kh) {
        __syncthreads();
        for (int idx = tid; idx < 24 * 512; idx += 256) {
          const int bi = idx >> 9, k = kh * 512 + (idx & 511);
          const float c = bi < 8 ? p.c_prompt[bi * D + k] : p.c_sample[(bi - 8) * D + k];
          cs[idx] = c / (1.0f + expf(-c));
        }
        __syncthreads();
        const float* wp = p.w_ada + ((size_t)layer * D + kh * 512 + kp * 32) * 3072 + cc * 16 + col;
#pragma unroll
        for (int k8 = 0; k8 < 32; k8 += 8) {
          float w[8];
#pragma unroll
          for (int u = 0; u < 8; ++u) w[u] = wp[(size_t)(k8 + u) * 3072];
#pragma unroll
          for (int bi = 0; bi < 24; ++bi) {
            const float4 c0 = *(const float4*)(cs + bi * 512 + kp * 32 + k8), c1 = *(const float4*)(cs + bi * 512 + kp * 32 + k8 + 4);
            acc[bi] += c0.x * w[0] + c0.y * w[1] + c0.z * w[2] + c0.w * w[3] + c1.x * w[4] + c1.y * w[5] + c1.z * w[6] + c1.w * w[7];
          }
        }
      }
      __syncthreads();
      float* red = (float*)lds;
#pragma unroll
      for (int bi = 0; bi < 24; ++bi) red[(kp * 24 + bi) * 16 + col] = acc[bi];
      __syncthreads();
      float* mod = (float*)(p.ws + W_MOD);
      for (int idx = tid; idx < 24 * 16; idx += 256) {
        const int bi = idx >> 4, c2 = idx & 15;
        float s = 0.f;
#pragma unroll
        for (int q = 0; q < 16; ++q) s += red[(q * 24 + bi) * 16 + c2];
        mod[(size_t)(bi * 2 + layer) * 3072 + cc * 16 + c2] = s + p.b_ada[layer * 3072 + cc * 16 + c2];
      }
      __syncthreads();
    } else if (it < 384 + 2112) {
      int t = it - 384;
      const float* W; bf16_t* Wt; int N, ntn;
      if (t < 512) { W = p.s5_w_in; Wt = (bf16_t*)(p.ws + W_S5IN); N = 2048; ntn = 32; }
      else if (t < 768) { t -= 512; W = p.s5_w_glu; Wt = (bf16_t*)(p.ws + W_GLU); N = 1024; ntn = 16; }
      else if (t < 1024) { t -= 768; W = p.s5_w_out; Wt = (bf16_t*)(p.ws + W_S5OUT); N = 1024; ntn = 16; }
      else if (t < 1856) { t -= 1024; W = p.gdn_w_in; Wt = (bf16_t*)(p.ws + W_GDNIN); N = 3088; ntn = 52; }
      else { t -= 1856; W = p.gdn_w_out; Wt = (bf16_t*)(p.ws + W_GDNOUT); N = 1024; ntn = 16; }
      const int tk = t / ntn, tn = t % ntn, k0 = tk * 64, n0 = tn * 64;
      float* tl = (float*)lds;
      const int tx = tid & 63, ty = tid >> 6;
#pragma unroll 4
      for (int i = 0; i < 16; ++i) {
        const int k = k0 + ty * 16 + i, n = n0 + tx;
        tl[(ty * 16 + i) * 65 + tx] = (n < N) ? W[(size_t)k * N + n] : 0.f;
      }
      __syncthreads();
#pragma unroll 4
      for (int i = 0; i < 16; ++i) {
        const int n = n0 + ty * 16 + i, k = k0 + tx;
        Wt[(size_t)n * 1024 + k] = f2bf(tl[tx * 65 + ty * 16 + i]);
      }
      __syncthreads();
    } else {
      const int t = it - 384 - 2112, g = t >> 2, d0 = (t & 3) * 8;
      float* sm = (float*)lds;
      float* Cr = sm; float* Ci = sm + 1024; float* Bbr = sm + 2048; float* Bbi = sm + 3072;
      float* Apr = sm + 4096; float* Api = sm + 4672; float* Wr = sm + 5248; float* Wi = sm + 6272;
      const float step = expf(p.s5_log_step[g]);
#pragma unroll
      for (int q = 0; q < 4; ++q) { const int idx = tid + q * 256; Cr[idx] = p.s5_c_re[g * 1024 + idx]; Ci[idx] = p.s5_c_im[g * 1024 + idx]; }
      if (tid < 64) {
        const int pp = tid;
        const float lr = p.s5_lam_re[g * 64 + pp], li = p.s5_lam_im[g * 64 + pp];
        const float mag = expf(lr * step);
        float sn, cn; sincosf(li * step, &sn, &cn);
        const float ar = mag * cn, ai = mag * sn;
        const float den = lr * lr + li * li, xr = ar - 1.0f;
        const float nr = (xr * lr + ai * li) / den, ni = (ai * lr - xr * li) / den;
#pragma unroll
        for (int c = 0; c < 16; ++c) {
          const float br = p.s5_b_re[(g * 64 + pp) * 16 + c], bi = p.s5_b_im[(g * 64 + pp) * 16 + c];
          Bbr[pp * 16 + c] = nr * br - ni * bi; Bbi[pp * 16 + c] = nr * bi + ni * br;
        }
        if (d0 == 0) {
          float* abar = (float*)(p.ws + W_ABAR);
          abar[(g * 64 + pp) * 2] = ar; abar[(g * 64 + pp) * 2 + 1] = ai;
          float* bb = (float*)(p.ws + W_BBAR);
#pragma unroll
          for (int c = 0; c < 16; ++c) {
            const float br = p.s5_b_re[(g * 64 + pp) * 16 + c], bi = p.s5_b_im[(g * 64 + pp) * 16 + c];
            bb[((g * 64 + pp) * 16 + c) * 2] = nr * br - ni * bi;
            bb[((g * 64 + pp) * 16 + c) * 2 + 1] = nr * bi + ni * br;
          }
        }
      }
#pragma unroll
      for (int q = 0; q < 3; ++q) {
        const int idx = tid + q * 256;
        if (idx < 576) {
          const int dd = idx >> 6, pp = idx & 63;
          const float lr = p.s5_lam_re[g * 64 + pp], li = p.s5_lam_im[g * 64 + pp];
          const float fd = (float)(d0 + dd);
          float s0, c0; sincosf(li * step * fd, &s0, &c0);
          const float m0 = expf(lr * step * fd);
          Apr[idx] = m0 * c0; Api[idx] = m0 * s0;
          if (d0 + dd == 32) { float* a64 = (float*)(p.ws + W_A64); a64[(g * 64 + pp) * 2] = m0 * c0; a64[(g * 64 + pp) * 2 + 1] = m0 * s0; }
        }
      }
      __syncthreads();
      bf16_t* ME = (bf16_t*)(p.ws + W_ME);
      bf16_t* MC = (bf16_t*)(p.ws + W_MC);
      bf16_t* KTb = (bf16_t*)(p.ws + W_KTAB);
      for (int dd = 0; dd < 8; ++dd) {
        const int d = d0 + dd;
#pragma unroll
        for (int q = 0; q < 4; ++q) {
          const int idx = tid + q * 256, pp = idx >> 4, c = idx & 15;
          const float ar = Apr[dd * 64 + pp], ai = Api[dd * 64 + pp], br = Bbr[idx], bi = Bbi[idx];
          const float wr_ = ar * br - ai * bi, wi_ = ar * bi + ai * br;
          Wr[idx] = wr_; Wi[idx] = wi_;
          ME[((size_t)(g * 128 + pp)) * 512 + (31 - d) * 16 + c] = f2bf(wr_);
          ME[((size_t)(g * 128 + 64 + pp)) * 512 + (31 - d) * 16 + c] = f2bf(wi_);
        }
        __syncthreads();
        {
          const int co = tid >> 4, ci = tid & 15;
          float s0 = 0.f, s1 = 0.f;
#pragma unroll 8
          for (int pp = 0; pp < 64; pp += 2) {
            s0 += Cr[co * 64 + pp] * Wr[pp * 16 + ci] - Ci[co * 64 + pp] * Wi[pp * 16 + ci];
            s1 += Cr[co * 64 + pp + 1] * Wr[(pp + 1) * 16 + ci] - Ci[co * 64 + pp + 1] * Wi[(pp + 1) * 16 + ci];
          }
          KTb[((size_t)(g * 16 + co) * 32 + d) * 16 + ci] = f2bf(s0 + s1);
        }
#pragma unroll
        for (int q = 0; q < 8; ++q) {
          const int idx = tid + q * 256, co = idx >> 7, k = idx & 127, pp = k & 63;
          const float cr = Cr[co * 64 + pp], cim = Ci[co * 64 + pp];
          const float a1r = Apr[(dd + 1) * 64 + pp], a1i = Api[(dd + 1) * 64 + pp];
          const float v = (k < 64) ? (cr * a1r - cim * a1i) : -(cr * a1i + cim * a1r);
          MC[((size_t)(g * 512 + d * 16 + co)) * 128 + k] = f2bf(v);
        }
        __syncthreads();
      }
    }
  }
}

DI void phase_norm_mod(const Params& p, const Sub& s, int layer, bool from_out, bf16_t* dst) {
  const int lane = VTID & 63, wave = VTID >> 6;
  const float* mod = (const float*)(p.ws + W_MOD);
  const float* gv = p.norm_g + layer * D;
  const int stride = s.vg * 4, rhi = s.samp ? M : MP;
  for (int r = (s.samp ? MP : 0) + s.vb * 4 + wave; r < rhi; r += 2 * stride) {
    const int rr[2] = {r, (r + stride < rhi) ? r + stride : r};
    const bool two = r + stride < rhi;
    float4 v[2][4], g4[4], sh[2][4], sc[2][4];
#pragma unroll
    for (int q = 0; q < 2; ++q) {
      if (from_out) {
        const bf16_t* srcb = (const bf16_t*)p.out + (size_t)rr[q] * D;
#pragma unroll
        for (int i = 0; i < 4; ++i) ld_bf4(srcb + i * 256 + lane * 4, v[q][i].x, v[q][i].y, v[q][i].z, v[q][i].w);
      } else {
        const float* src = xrow(p, rr[q]);
#pragma unroll
        for (int i = 0; i < 4; ++i) v[q][i] = ldnt4(src + i * 256 + lane * 4);
      }
      const float* mrow = mod + (size_t)(row_bi(rr[q]) * 2 + layer) * 3072;
#pragma unroll
      for (int i = 0; i < 4; ++i) { const int c = i * 256 + lane * 4; sh[q][i] = *(const float4*)(mrow + c); sc[q][i] = *(const float4*)(mrow + 1024 + c); }
    }
#pragma unroll
    for (int i = 0; i < 4; ++i) g4[i] = *(const float4*)(gv + i * 256 + lane * 4);
#pragma unroll
    for (int q = 0; q < 2; ++q) {
      float ss = 0.f;
#pragma unroll
      for (int i = 0; i < 4; ++i) ss += v[q][i].x * v[q][i].x + v[q][i].y * v[q][i].y + v[q][i].z * v[q][i].z + v[q][i].w * v[q][i].w;
      ss = wave_sum(ss);
      const float rs = rsqrtf(ss * (1.0f / D) + EPS);
      if (q == 0 || two) {
#pragma unroll
        for (int i = 0; i < 4; ++i) {
          const int c = i * 256 + lane * 4;
          st_bf4(dst + (size_t)rr[q] * D + c, v[q][i].x * rs * g4[i].x * (1.f + sc[q][i].x) + sh[q][i].x, v[q][i].y * rs * g4[i].y * (1.f + sc[q][i].y) + sh[q][i].y,
                 v[q][i].z * rs * g4[i].z * (1.f + sc[q][i].z) + sh[q][i].z, v[q][i].w * rs * g4[i].w * (1.f + sc[q][i].w) + sh[q][i].w);
        }
      }
    }
  }
}

DI void phase_g1(const Params& p, const Sub& s, char* lds_all) {
  const bf16_t* A = (const bf16_t*)(p.ws + W_SLOT0);
  const bf16_t* Bt = (const bf16_t*)(p.ws + W_S5IN);
  bf16_t* ugm = (bf16_t*)(p.ws + W_SLOT1);
  bf16_t* z = (bf16_t*)(p.ws + W_SLOT2);
  float* us = (float*)(p.ws + W_USAMP);
  {
    gemm_dispatch(s, lds_all, A, Bt, 8,
      [&](int, int) { return NoLoad{}; },
      [&](int row, int col, f32x4 v, const NoLoad&) {
        if (col < 1024) {
          if (row < MP) st_bf4(ugm + ((size_t)(col >> 4) * MP + row) * 16 + (col & 15), v[0], v[1], v[2], v[3]);
          else *(f32x4*)(us + (size_t)(row - MP) * D + col) = v;
        } else st_bf4(z + (size_t)row * D + (col - 1024), v[0], v[1], v[2], v[3]);
      });
  }
}

DI void phase_s5_e(const Params& p, char* lds) {
  const bf16_t* ugm = (const bf16_t*)(p.ws + W_SLOT1);
  const bf16_t* ME = (const bf16_t*)(p.ws + W_ME);
  float* E = (float*)(p.ws + W_E);
  const int nt = 64 * 16;
  for (int k_ = 0; k_ * VGRID < (nt); ++k_) {
    int L = k_ * VGRID + VBID; const bool active_ = L < (nt); if (!active_) L = (nt) - 1;
    const int g = L >> 4, mt = L & 15;
    const bf16_t* Ag = ugm + (size_t)g * MP * 16 + (size_t)mt * 128 * 512;
    gemm_tile(lds, 8, mt & 7,
      [&](int r, int kc) { return Ag + (size_t)r * 512 + kc * 8; },
      [&](int n, int kc) { return ME + (size_t)(g * 128 + n) * 512 + kc * 8; },
      [&](int r, int c, f32x4 v) { *(f32x4*)(E + ((size_t)g * 2048 + mt * 128 + r) * 128 + c) = v; });
  }
}

DI void phase_s5_sample(const Params& p, const Sub& s) {
  const int lane = VTID & 63, wave = VTID >> 6;
  const float* us = (const float*)(p.ws + W_USAMP);
  const float* abar = (const float*)(p.ws + W_ABAR);
  const float* bb = (const float*)(p.ws + W_BBAR);
  bf16_t* yg = (bf16_t*)(p.ws + W_SLOT3);
  for (int it = s.vb * 4 + wave; it < 1024; it += s.vg * 4) {
    const int b = it >> 6, g = it & 63;
    float xr = p.st_s5_re[(b * 64 + g) * 64 + lane], xi = p.st_s5_im[(b * 64 + g) * 64 + lane];
    const float ar = abar[(g * 64 + lane) * 2], ai = abar[(g * 64 + lane) * 2 + 1];
    float bbr[16], bbi[16], cr[16], ci[16];
#pragma unroll
    for (int c = 0; c < 16; ++c) {
      bbr[c] = bb[((g * 64 + lane) * 16 + c) * 2]; bbi[c] = bb[((g * 64 + lane) * 16 + c) * 2 + 1];
      cr[c] = p.s5_c_re[(g * 16 + c) * 64 + lane]; ci[c] = p.s5_c_im[(g * 16 + c) * 64 + lane];
    }
    const float dch = p.s5_d[g * 16 + (lane & 15)];
    for (int t = 0; t < 16; ++t) {
      const float* up = us + (size_t)(b * 16 + t) * D + g * 16;
      float br = 0.f, bi = 0.f;
#pragma unroll
      for (int c = 0; c < 16; ++c) { const float u = up[c]; br += bbr[c] * u; bi += bbi[c] * u; }
      const float nxr = ar * xr - ai * xi + br, nxi = ar * xi + ai * xr + bi;
      xr = nxr; xi = nxi;
      float yv = 0.f;
#pragma unroll
      for (int c = 0; c < 16; ++c) { const float s = wave_sum(cr[c] * xr - ci[c] * xi); if (lane == c) yv = s; }
      if (lane < 16) {
        const float u = up[lane];
        yg[(size_t)(MP + b * 16 + t) * D + g * 16 + lane] = f2bf(geluf_(yv + dch * u));
      }
    }
    p.out[O_S5RE_S + (b * 64 + g) * 64 + lane] = xr;
    p.out[O_S5IM_S + (b * 64 + g) * 64 + lane] = xi;
  }
}

DI void phase_s5_scan(const Params& p) {
  const float* E = (const float*)(p.ws + W_E);
  const float* a64 = (const float*)(p.ws + W_A64);
  bf16_t* H = (bf16_t*)(p.ws + W_H);
  for (int idx = VBID * 256 + VTID; idx < 8 * 64 * 64; idx += VGRID * 256) {
    const int pp = idx & 63, g = (idx >> 6) & 63, b = idx >> 12;
    const float ar = a64[(g * 64 + pp) * 2], ai = a64[(g * 64 + pp) * 2 + 1];
    float hr = 0.f, hi = 0.f;
    const size_t base = ((size_t)g * 2048 + b * 256) * 128;
    for (int n0 = 0; n0 < 256; n0 += 8) {
      float er[8], ei[8];
#pragma unroll
      for (int k = 0; k < 8; ++k) { er[k] = E[base + (size_t)(n0 + k) * 128 + pp]; ei[k] = E[base + (size_t)(n0 + k) * 128 + 64 + pp]; }
#pragma unroll
      for (int k = 0; k < 8; ++k) {
        H[base + (size_t)(n0 + k) * 128 + pp] = f2bf(hr); H[base + (size_t)(n0 + k) * 128 + 64 + pp] = f2bf(hi);
        const float nr = ar * hr - ai * hi + er[k], ni = ar * hi + ai * hr + ei[k];
        hr = nr; hi = ni;
      }
    }
    p.out[O_S5RE_P + (b * 64 + g) * 64 + pp] = hr;
    p.out[O_S5IM_P + (b * 64 + g) * 64 + pp] = hi;
  }
}

DI void phase_s5_y(const Params& p, char* lds) {
  const bf16_t* ugm = (const bf16_t*)(p.ws + W_SLOT1);
  const bf16_t* H = (const bf16_t*)(p.ws + W_H);
  const bf16_t* MC = (const bf16_t*)(p.ws + W_MC);
  const bf16_t* KT = (const bf16_t*)(p.ws + W_KTAB);
  bf16_t* yg = (bf16_t*)(p.ws + W_SLOT3);
  const bf16_t* zblk = (const bf16_t*)(p.ws + W_ZERO);
  const int nt = 64 * 8 * 8;
  for (int k_ = 0; k_ * VGRID < (nt); ++k_) {
    int L = k_ * VGRID + VBID; const bool active_ = L < (nt); if (!active_) L = (nt) - 1;
    const int j = 3 - (L >> 10), rem = L & 1023, g = rem >> 4, mt = rem & 15;
    const bf16_t* Ug = ugm + (size_t)g * MP * 16 + (size_t)mt * 128 * 512;
    const bf16_t* Hg = H + ((size_t)g * 2048 + mt * 128) * 128;
    gemm_tile(lds, 2 + 2 * (j + 1), 0,
      [&](int r, int kc) { return kc < 16 ? Hg + (size_t)r * 128 + kc * 8 : Ug + (size_t)r * 512 + (kc - 16) * 8; },
      [&](int n, int kc) {
        const int nn = j * 128 + n;
        if (kc < 16) return MC + ((size_t)g * 512 + nn) * 128 + kc * 8;
        const int t = nn >> 4, co = nn & 15, kk = (kc - 16) * 8, s = kk >> 4, ci0 = kk & 15;
        if (s > t) return zblk;
        return KT + ((size_t)(g * 16 + co) * 32 + (t - s)) * 16 + ci0;
      },
      [&](int r, int c) {
        const int nn = j * 128 + c, t = nn >> 4, co = nn & 15, cr = mt * 128 + r;
        const size_t tok = (size_t)cr * 32 + t;
        LdY l; l.u = *(const uint2*)(ugm + ((size_t)g * MP + tok) * 16 + co); l.d = *(const float4*)(p.s5_d + g * 16 + co);
        return l;
      },
      [&](int r, int c, f32x4 v, const LdY& ly) {
        const uint2 uu = ly.u;
        const int nn = j * 128 + c, t = nn >> 4, co = nn & 15, cr = mt * 128 + r;
        const size_t tok = (size_t)cr * 32 + t;
        const float u0 = __uint_as_float(uu.x << 16), u1 = __uint_as_float(uu.x & 0xffff0000u), u2 = __uint_as_float(uu.y << 16), u3 = __uint_as_float(uu.y & 0xffff0000u);
        const float4 d4 = ly.d;
        st_bf4(yg + tok * D + g * 16 + co, geluf_(v[0] + d4.x * u0), geluf_(v[1] + d4.y * u1), geluf_(v[2] + d4.z * u2), geluf_(v[3] + d4.w * u3));
      });
  }
}

DI void phase_g2(const Params& p, const Sub& s, char* lds_all) {
  const bf16_t* A = (const bf16_t*)(p.ws + W_SLOT3);
  const bf16_t* Bt = (const bf16_t*)(p.ws + W_GLU);
  const bf16_t* z = (const bf16_t*)(p.ws + W_SLOT2);
  bf16_t* y2 = (bf16_t*)(p.ws + W_SLOT0);
  {
    gemm_dispatch(s, lds_all, A, Bt, 4,
      [&](int row, int col) { const size_t o = (size_t)row * D + col; Ld2 r; const uint2 a = *(const uint2*)(A + o), b = *(const uint2*)(z + o);
        r.a.x = __uint_as_float(a.x); r.a.y = __uint_as_float(a.y); r.a.z = __uint_as_float(b.x); r.a.w = __uint_as_float(b.y); r.b = *(const float4*)(p.s5_b_glu + col); return r; },
      [&](int row, int col, f32x4 v, const Ld2& l2) {
        uint4 ld; ld.x = __float_as_uint(l2.a.x); ld.y = __float_as_uint(l2.a.y); ld.z = __float_as_uint(l2.a.z); ld.w = __float_as_uint(l2.a.w);
        const size_t o = (size_t)row * D + col;
        const float y0 = __uint_as_float(ld.x << 16), y1 = __uint_as_float(ld.x & 0xffff0000u), y2_ = __uint_as_float(ld.y << 16), y3 = __uint_as_float(ld.y & 0xffff0000u);
        const float z0 = __uint_as_float(ld.z << 16), z1 = __uint_as_float(ld.z & 0xffff0000u), z2 = __uint_as_float(ld.w << 16), z3 = __uint_as_float(ld.w & 0xffff0000u);
        const float4 b4 = l2.b;
        st_bf4(y2 + o, y0 * sigmoidf_(v[0] + b4.x) * siluf_(z0), y1 * sigmoidf_(v[1] + b4.y) * siluf_(z1),
               y2_ * sigmoidf_(v[2] + b4.z) * siluf_(z2), y3 * sigmoidf_(v[3] + b4.w) * siluf_(z3));
      });
  }
}

DI void phase_gout(const Params& p, const Sub& s, char* lds_all, int layer, const bf16_t* A, const bf16_t* Bt) {
  const float* mod = (const float*)(p.ws + W_MOD);
  {
    gemm_dispatch(s, lds_all, A, Bt, 4,
      [&](int row, int col) {
        const bf16_t* x1b = (const bf16_t*)p.out;
        float4 x4;
        if (layer == 0) x4 = ldnt4(xrow(p, row) + col);
        else ld_bf4(x1b + (size_t)row * D + col, x4.x, x4.y, x4.z, x4.w);
        Ld2 r; r.a = x4; r.b = *(const float4*)(mod + (size_t)(row_bi(row) * 2 + layer) * 3072 + 2048 + col);
        return r;
      },
      [&](int row, int col, f32x4 v, const Ld2& l2) {
        const float4 x4 = l2.a, g4 = l2.b;
        bf16_t* x1b = (bf16_t*)p.out;
        bf16_t* x2b = (bf16_t*)(p.ws + W_SLOT3);
        st_bf4((layer == 0 ? x1b : x2b) + (size_t)row * D + col, x4.x + g4.x * v[0], x4.y + g4.y * v[1], x4.z + g4.z * v[2], x4.w + g4.w * v[3]);
      });
  }
}

DI void phase_g4(const Params& p, const Sub& s, char* lds_all) {
  const bf16_t* A = (const bf16_t*)(p.ws + W_SLOT0);
  const bf16_t* Bt = (const bf16_t*)(p.ws + W_GDNIN);
  bf16_t* qkv = (bf16_t*)(p.ws + W_SLOT2);
  bf16_t* z1 = (bf16_t*)(p.ws + W_SLOT1);
  float* ba = (float*)(p.ws + W_BA);
  {
    gemm_dispatch(s, lds_all, A, Bt, s.samp ? 13 : 12,
      [&](int, int) { return NoLoad{}; },
      [&](int row, int col, f32x4 v, const NoLoad&) {
        if (col < 2048) {
          st_bf4(qkv + (size_t)row * 2048 + col, v[0], v[1], v[2], v[3]);
          if (row < MP) { const int l = row & 8191; if (l >= 8189) *(f32x4*)(p.out + O_CONV_P + ((size_t)(row >> 13) * 3 + (l - 8189)) * 2048 + col) = v; }
          else { const int l = (row - MP) & 15; if (l >= 13) *(f32x4*)(p.out + O_CONV_S + ((size_t)((row - MP) >> 4) * 3 + (l - 13)) * 2048 + col) = v; }
        } else if (col < 3072) st_bf4(z1 + (size_t)row * D + (col - 2048), v[0], v[1], v[2], v[3]);
        else if (col < 3088) *(f32x4*)(ba + (size_t)row * 16 + (col - 3072)) = v;
      });
  }
  if (!s.samp) {
    const int tidx = otid(), wid = tidx >> 6, lane = tidx & 63, fr = lane & 15, fq = lane >> 4;
    for (int rt = blockIdx.x; rt < 256; rt += gridDim.x) {
      const int r0 = rt * 256 + wid * 32;
      const bf16_t* a0p = A + (size_t)(r0 + fr) * D + fq * 8;
      const bf16_t* a1p = a0p + (size_t)16 * D;
      const bf16_t* bp = Bt + (size_t)(3072 + fr) * D + fq * 8;
      f32x4 c0 = (f32x4){0.f, 0.f, 0.f, 0.f}, c1 = (f32x4){0.f, 0.f, 0.f, 0.f};
#pragma unroll 8
      for (int ks = 0; ks < 32; ++ks) {
        const bf16x8 bb = *(const bf16x8*)(bp + ks * 32);
        const bf16x8 x0 = *(const bf16x8*)(a0p + ks * 32), x1 = *(const bf16x8*)(a1p + ks * 32);
        c0 = MFMA16(bb, x0, c0); c1 = MFMA16(bb, x1, c1);
      }
      *(f32x4*)(ba + (size_t)(r0 + fr) * 16 + 4 * fq) = c0;
      *(f32x4*)(ba + (size_t)(r0 + 16 + fr) * 16 + 4 * fq) = c1;
    }
  }
}

DI void phase_gdn_prep(const Params& p, const Sub& s, char* lds) {
  const bf16_t* qkv = (const bf16_t*)(p.ws + W_SLOT2);
  const float* ba = (const float*)(p.ws + W_BA);
  bf16_t* GW = (bf16_t*)(p.ws + W_GW); bf16_t* GU = (bf16_t*)(p.ws + W_GU); bf16_t* GQK = (bf16_t*)(p.ws + W_GQK);
  bf16_t* GQ = (bf16_t*)(p.ws + W_GQ); bf16_t* GKT = (bf16_t*)(p.ws + W_GKT); float* GGC = (float*)(p.ws + W_GGC);
  char* R0 = lds; char* R1 = lds + 16384; char* R2 = lds + 32768; char* R3 = lds + 49152;
  const int it_lo = s.samp ? 4096 : 0, it_n = s.samp ? 64 : 4096;
  for (int k_ = 0; k_ * s.vg < it_n; ++k_) {
    int it = k_ * s.vg + s.vb;
    if (k_ * s.vg + (s.vb & ~1) >= it_n) continue;
    if (it >= it_n) it = it_n - 1;
    it += it_lo;
    const int cid = it >> 2, hq = it & 3;
    f32x4 akk[4], aqk[4];
#pragma unroll
    for (int hvi = 0; hvi < 2; ++hvi) {
    const int hv = 2 * hq + hvi;
    const int tid = VTID, lane = tid & 63, wave = tid >> 6, fr = lane & 15, fq = lane >> 4;
    const bool samp = cid >= 1024;
    const int row0 = samp ? MP + (cid - 1024) * 16 : cid * 64;
    const int tv = samp ? 16 : 64;
    const bool first = samp ? false : ((cid & 127) == 0);
    const int sb = cid - 1024;
    float beta = 0.f, gg = 0.f;
    if (lane < tv) {
      const float braw = ba[(size_t)(row0 + lane) * 16 + hv], araw = ba[(size_t)(row0 + lane) * 16 + 8 + hv];
      beta = sigmoidf_(braw);
      const float xx = araw + p.gdn_dt_bias[hv];
      const float sp = xx > 20.f ? xx : log1pf(expf(xx));
      gg = -expf(p.gdn_a_log[hv]) * sp;
    }
    float gcum = gg;
#pragma unroll
    for (int o = 1; o < 64; o <<= 1) { const float t = __shfl_up(gcum, o); if (lane >= o) gcum += t; }
    if (wave == 0) {
      const float gl_ = __shfl(gcum, 63);
      float* ge = GGC + ((size_t)cid * 8 + hv) * 256;
      ge[lane] = __expf(gcum); ge[64 + lane] = __expf(gl_ - gcum);
      if (lane == 0) ge[128] = __expf(gl_);
    }
    const int ln = lane;
    const bool hist_ok = !samp && !first;
#pragma unroll
    for (int seg = 0; seg < 3; ++seg) {
      if (seg < 2 && hvi == 1) continue;
      const int cb = seg == 0 ? hq * 128 : (seg == 1 ? 512 + hq * 128 : 1024 + hv * 128);
      const int ch = cb + 2 * ln;
      const float2 w0 = *(const float2*)(p.gdn_conv_w + 0 * 2048 + ch), w1 = *(const float2*)(p.gdn_conv_w + 1 * 2048 + ch);
      const float2 w2 = *(const float2*)(p.gdn_conv_w + 2 * 2048 + ch), w3 = *(const float2*)(p.gdn_conv_w + 3 * 2048 + ch);
      const int t0 = wave * 16, d0 = 2 * ln;
      float2 xs[19];
      {
        unsigned xu[19];
#pragma unroll
        for (int j = 0; j < 19; ++j) {
          const int trel = t0 - 3 + j;
          const bool ok = (trel < tv) && (trel >= 0 || hist_ok);
          xu[j] = *(const unsigned*)(qkv + (size_t)(ok ? row0 + trel : row0) * 2048 + ch);
        }
#pragma unroll
        for (int j = 0; j < 19; ++j) {
          const int trel = t0 - 3 + j;
          const bool ok = (trel < tv) && (trel >= 0 || hist_ok);
          xs[j].x = ok ? __uint_as_float(xu[j] << 16) : 0.f; xs[j].y = ok ? __uint_as_float(xu[j] & 0xffff0000u) : 0.f;
        }
        if (samp && wave == 0) {
#pragma unroll
          for (int j = 0; j < 3; ++j) xs[j] = *(const float2*)(p.st_conv + ((size_t)sb * 3 + j) * 2048 + ch);
        }
      }
      unsigned tp0[8], tp1[8];
      float a0v[16], a1v[16], ssv[16];
#pragma unroll
      for (int tt = 0; tt < 16; ++tt) {
        a0v[tt] = siluf_(w0.x * xs[tt].x + w1.x * xs[tt + 1].x + w2.x * xs[tt + 2].x + w3.x * xs[tt + 3].x);
        a1v[tt] = siluf_(w0.y * xs[tt].y + w1.y * xs[tt + 1].y + w2.y * xs[tt + 2].y + w3.y * xs[tt + 3].y);
        ssv[tt] = a0v[tt] * a0v[tt] + a1v[tt] * a1v[tt];
      }
      if (seg < 2) {
#pragma unroll
        for (int o = 32; o >= 1; o >>= 1) {
#pragma unroll
          for (int tt = 0; tt < 16; ++tt) ssv[tt] += __shfl_xor(ssv[tt], o);
        }
      }
#pragma unroll
      for (int tt = 0; tt < 16; ++tt) {
        const int t = t0 + tt;
        float a0 = a0v[tt], a1 = a1v[tt];
        if (seg < 2) {
          float rs = rsqrtf(ssv[tt] + EPS);
          if (seg == 0) rs *= 0.08838834764831845f;
          a0 *= rs; a1 *= rs;
        }
        if (t >= tv) { a0 = 0.f; a1 = 0.f; }
        if (seg == 0) {
          *(unsigned*)(R2 + t * 256 + (((d0 >> 3) ^ (t & 7)) << 4) + (d0 & 7) * 2) = pack2(a0, a1);
          *(unsigned*)(GQ + (((size_t)cid * 4 + hq) * 64 + t) * 128 + kperm(d0)) = pack2(a0, a1);
        } else {
          if (seg == 1) *(unsigned*)(R0 + t * 256 + (((d0 >> 3) ^ (t & 7)) << 4) + (d0 & 7) * 2) = pack2(a0, a1);
          a0v[tt] = a0; a1v[tt] = a1;
        }
      }
      if (seg >= 1) {
#pragma unroll
        for (int q = 0; q < 8; ++q) { tp0[q] = pack2(a0v[2 * q], a0v[2 * q + 1]); tp1[q] = pack2(a1v[2 * q], a1v[2 * q + 1]); }
      }
      if (seg >= 1) {
        char* dst = seg == 1 ? R1 : R3;
#pragma unroll
        for (int h = 0; h < 2; ++h) {
          const int chk = 2 * wave + h;
          uint4 v0, v1;
          v0.x = tp0[4 * h]; v0.y = tp0[4 * h + 1]; v0.z = tp0[4 * h + 2]; v0.w = tp0[4 * h + 3];
          v1.x = tp1[4 * h]; v1.y = tp1[4 * h + 1]; v1.z = tp1[4 * h + 2]; v1.w = tp1[4 * h + 3];
          *(uint4*)(dst + d0 * 128 + ((chk ^ (d0 & 7)) << 4)) = v0;
          *(uint4*)(dst + (d0 + 1) * 128 + ((chk ^ ((d0 + 1) & 7)) << 4)) = v1;
        }
      }
    }
    lds_barrier();
    if (hvi == 0) {
#pragma unroll
    for (int n = 0; n < 4; ++n) { akk[n] = (f32x4){0.f, 0.f, 0.f, 0.f}; aqk[n] = (f32x4){0.f, 0.f, 0.f, 0.f}; }
#pragma unroll
    for (int ks = 0; ks < 4; ++ks) {
      const bf16x8 ak = ldfrag(R0, 256, wave * 16 + fr, ks * 4 + fq), aq = ldfrag(R2, 256, wave * 16 + fr, ks * 4 + fq);
#pragma unroll
      for (int n = 0; n < 4; ++n) {
        const bf16x8 bk = ldfrag(R0, 256, n * 16 + fr, ks * 4 + fq);
        akk[n] = MFMA16(ak, bk, akk[n]); aqk[n] = MFMA16(aq, bk, aqk[n]);
      }
    }
    }
    lds_barrier();
    {
      float* Mx = (float*)R0;
#pragma unroll
      for (int n = 0; n < 4; ++n) {
        const int jj = n * 16 + fr;
        const float gj = __shfl(gcum, jj);
#pragma unroll
        for (int j = 0; j < 4; ++j) {
          const int i = wave * 16 + 4 * fq + j;
          const float gi = __shfl(gcum, i), bi = __shfl(beta, i);
          const float dec = (i >= jj) ? __expf(gi - gj) : 0.f;
          Mx[i * 64 + jj] = (i > jj) ? bi * akk[n][j] * dec : 0.f;
          GQK[(((size_t)cid * 8 + hv) * 64 + i) * 64 + kperm(jj)] = f2bf(aqk[n][j] * dec);
        }
      }
    }
    lds_barrier();
    if ((hv & 1) == 0) {
#pragma unroll
      for (int q = 0; q < 4; ++q) {
        const int Lc = tid + q * 256, row = Lc >> 3, ch = Lc & 7;
        { const uint4 v_ = *(const uint4*)(R1 + row * 128 + ((ch ^ (row & 7)) << 4)); bf16_t* d_ = GKT + (((size_t)cid * 4 + hq) * 128 + row) * 64;
          uint2 lo_, hi_; lo_.x = v_.x; lo_.y = v_.y; hi_.x = v_.z; hi_.y = v_.w;
          *(uint2*)(d_ + kperm(ch * 8)) = lo_; *(uint2*)(d_ + kperm(ch * 8 + 4)) = hi_; }
      }
    }
    {
      const float* Mx = (const float*)R0;
      bf16_t* XT = (bf16_t*)R2;
      bf16_t* Xr = (bf16_t*)(R2 + 8192);
      {
        const int a = wave, c = lane & 15;
        float x[16];
#pragma unroll
        for (int i = 0; i < 16; ++i) {
          const float mrow = Mx[(16 * a + i) * 64 + 16 * a + c];
          float s0 = (c == i) ? 1.f : 0.f, s1 = 0.f;
#pragma unroll
          for (int j = 0; j < i; ++j) {
            const float mv = __int_as_float(__builtin_amdgcn_readlane(__float_as_int(mrow), j));
            if (j & 1) s1 -= mv * x[j]; else s0 -= mv * x[j];
          }
          x[i] = s0 + s1;
        }
        if (lane < 16) {
#pragma unroll
          for (int i = 0; i < 16; ++i) Xr[(16 * a + i) * 64 + 16 * a + c] = f2bf(x[i]);
          uint4 v0, v1;
          v0.x = pack2(x[0], x[1]); v0.y = pack2(x[2], x[3]); v0.z = pack2(x[4], x[5]); v0.w = pack2(x[6], x[7]);
          v1.x = pack2(x[8], x[9]); v1.y = pack2(x[10], x[11]); v1.z = pack2(x[12], x[13]); v1.w = pack2(x[14], x[15]);
          *(uint4*)(XT + (16 * a + c) * 64 + 16 * a) = v0;
          *(uint4*)(XT + (16 * a + c) * 64 + 16 * a + 8) = v1;
        }
      }
      lds_barrier();
      typedef unsigned u32x4 __attribute__((ext_vector_type(4)));
#pragma unroll
      for (int a = 1; a < 4; ++a) {
        if (wave < a) {
          const int b = wave, len = 16 * (a - b);
          f32x4 T = (f32x4){0.f, 0.f, 0.f, 0.f};
#pragma unroll
          for (int kk = 0; kk < 2; ++kk) {
            if (kk * 32 < len) {
              const int k0 = kk * 32 + fq * 8;
              u32x4 av = (u32x4){0u, 0u, 0u, 0u}, bv = (u32x4){0u, 0u, 0u, 0u};
              if (k0 < len) {
                const float* mp = Mx + (16 * a + fr) * 64 + 16 * b + k0;
                const float4 m0 = *(const float4*)mp, m1 = *(const float4*)(mp + 4);
                av[0] = pack2(m0.x, m0.y); av[1] = pack2(m0.z, m0.w); av[2] = pack2(m1.x, m1.y); av[3] = pack2(m1.z, m1.w);
                bv = *(const u32x4*)(XT + (16 * b + fr) * 64 + 16 * b + k0);
              }
              T = MFMA16(__builtin_bit_cast(bf16x8, av), __builtin_bit_cast(bf16x8, bv), T);
            }
          }
          const uint2 dv = *(const uint2*)(Xr + (16 * a + fr) * 64 + 16 * a + 4 * fq);
          u32x4 ad = (u32x4){dv.x, dv.y, 0u, 0u}, bt = (u32x4){pack2(T[0], T[1]), pack2(T[2], T[3]), 0u, 0u};
          const f32x4 Xab = MFMA16(__builtin_bit_cast(bf16x8, ad), __builtin_bit_cast(bf16x8, bt), ((f32x4){0.f, 0.f, 0.f, 0.f}));
          uint2 xo; xo.x = pack2(-Xab[0], -Xab[1]); xo.y = pack2(-Xab[2], -Xab[3]);
          *(uint2*)(XT + (16 * b + fr) * 64 + 16 * a + 4 * fq) = xo;
#pragma unroll
          for (int j = 0; j < 4; ++j) Xr[(16 * a + 4 * fq + j) * 64 + 16 * b + fr] = f2bf(-Xab[j]);
        }
        lds_barrier();
      }
      {
        const int i = tid >> 2, cg = tid & 3;
        const uint4 r0 = *(const uint4*)(Xr + i * 64 + cg * 16), r1 = *(const uint4*)(Xr + i * 64 + cg * 16 + 8);
        const unsigned rw[8] = {r0.x, r0.y, r0.z, r0.w, r1.x, r1.y, r1.z, r1.w};
        float aw[16], au[16];
#pragma unroll
        for (int q = 0; q < 16; ++q) {
          const int j = cg * 16 + q;
          const float bj = __shfl(beta, j), gj = __shfl(gcum, j);
          const float xraw = (q & 1) ? __uint_as_float(rw[q >> 1] & 0xffff0000u) : __uint_as_float(rw[q >> 1] << 16);
          const float xx = ((i >> 4) >= cg) ? xraw : 0.f;
          au[q] = xx * bj; aw[q] = xx * bj * __expf(gj);
        }
        lds_barrier();
#pragma unroll
        for (int h = 0; h < 2; ++h) {
          uint4 vw, vu;
          vw.x = pack2(aw[8 * h], aw[8 * h + 1]); vw.y = pack2(aw[8 * h + 2], aw[8 * h + 3]); vw.z = pack2(aw[8 * h + 4], aw[8 * h + 5]); vw.w = pack2(aw[8 * h + 6], aw[8 * h + 7]);
          vu.x = pack2(au[8 * h], au[8 * h + 1]); vu.y = pack2(au[8 * h + 2], au[8 * h + 3]); vu.z = pack2(au[8 * h + 4], au[8 * h + 5]); vu.w = pack2(au[8 * h + 6], au[8 * h + 7]);
          const int o = i * 128 + (((2 * cg + h) ^ (i & 7)) << 4);
          *(uint4*)(R2 + o) = vw; *(uint4*)(R2 + 8192 + o) = vu;
        }
      }
    }
    lds_barrier();
    {
      const bf16x8 aw0 = ldfrag(R2, 128, wave * 16 + fr, fq), aw1 = ldfrag(R2, 128, wave * 16 + fr, 4 + fq);
      const bf16x8 au0 = ldfrag(R2 + 8192, 128, wave * 16 + fr, fq), au1 = ldfrag(R2 + 8192, 128, wave * 16 + fr, 4 + fq);
      const size_t ob = (((size_t)cid * 8 + hv) * 64 + wave * 16 + fr) * 128;
#pragma unroll
      for (int n = 0; n < 8; ++n) {
        f32x4 cw = (f32x4){0.f, 0.f, 0.f, 0.f}, cu = (f32x4){0.f, 0.f, 0.f, 0.f};
        cw = MFMA16(ldfrag(R1, 128, n * 16 + fr, fq), aw0, cw); cw = MFMA16(ldfrag(R1, 128, n * 16 + fr, 4 + fq), aw1, cw);
        cu = MFMA16(au0, ldfrag(R3, 128, n * 16 + fr, fq), cu); cu = MFMA16(au1, ldfrag(R3, 128, n * 16 + fr, 4 + fq), cu);
        st_bf4(GW + ob + kperm(n * 16 + 4 * fq), cw[0], cw[1], cw[2], cw[3]);
        st_bf4(GU + ((size_t)cid * 8 + hv) * 8192 + ((n * 4 + wave) * 64 + lane) * 4, cu[0], cu[1], cu[2], cu[3]);
      }
    }
    lds_barrier();
    }
  }
}

DI void phase_gdn_seq(const Params& p, const Sub& s, char* lds_all) {
  const int tid = VTID, lane = tid & 63, wave = tid >> 6, fr = lane & 15, fq = lane >> 4;
  const bf16_t* GW = (const bf16_t*)(p.ws + W_GW); const bf16_t* GU = (const bf16_t*)(p.ws + W_GU); const bf16_t* GQK = (const bf16_t*)(p.ws + W_GQK);
  const bf16_t* GQ = (const bf16_t*)(p.ws + W_GQ); const bf16_t* GKT = (const bf16_t*)(p.ws + W_GKT); const float* GGC = (const float*)(p.ws + W_GGC);
  bf16_t* O = (bf16_t*)(p.ws + W_SLOT0);
  for (int rb = blockIdx.x; rb < 256; rb += gridDim.x) {
    if ((rb >= 128) != s.samp) continue;
    const int hh = otid() >> 8;
    const bool act = rb >= 128 || hh == 0;
    const int it = rb < 128 ? rb : 128 + (rb - 128) * 2 + hh;
    const bool samp = it >= 128;
    int b, hv, half, nsteps, cid0;
    if (!samp) { b = it >> 4; hv = (it >> 1) & 7; half = it & 1; nsteps = 128; cid0 = b * 128; }
    else { const int s = it - 128; b = s >> 4; hv = (s >> 1) & 7; half = s & 1; nsteps = 1; cid0 = 1024 + b; }
    const int hq = hv >> 1, dv0 = half * 64 + wave * 16;
    const int tv = samp ? 16 : 64;
    f32x4 S[8];
#pragma unroll
    for (int m = 0; m < 8; ++m) {
      S[m] = (f32x4){0.f, 0.f, 0.f, 0.f};
      if (samp && act) {
#pragma unroll
        for (int j = 0; j < 4; ++j) S[m][j] = p.st_gdn[(((size_t)b * 8 + hv) * 128 + m * 16 + 4 * fq + j) * 128 + dv0 + fr];
      }
    }
#define DMA_GT(cid_, slot_) do { if (wave == 0) __builtin_amdgcn_global_load_lds((const unsigned*)(GGC + ((size_t)(cid_) * 8 + hv) * 256 + lane * 4), \
      (LAS unsigned*)((LAS char*)lds_all + 131072 + (slot_) * 1024 + lane * 16), 16, 0, 0); } while (0)
    char* lbase = rb < 128 ? lds_all : lds_all + ((otid() >> 8) << 16);
    LAS char* l3 = (LAS char*)lbase;
#define DMA16(gp, loff) __builtin_amdgcn_global_load_lds((const unsigned*)(gp), (LAS unsigned*)(l3 + boff__ + (loff)), 16, 0, 0)
#define DMA_WU(cid_, bo_) do { const int cid__ = (cid_); const int boff__ = (bo_); \
      const bf16_t* sw = GW + ((size_t)cid__ * 8 + hv) * 8192; \
      const bf16_t* su = GU + ((size_t)cid__ * 8 + hv) * 8192 + half * 4096; \
      _Pragma("unroll") for (int i = 0; i < 4; ++i) { const int id = tid + i * 256, r = id >> 4, c = (id & 15) ^ (r & 7); DMA16(sw + r * 128 + c * 8, id * 16); } \
      _Pragma("unroll") for (int i = 0; i < 2; ++i) { const int id = tid + i * 256, r = id >> 3, c = id & 7; DMA16(su + id * 8, 57344 + id * 16); } } while (0)
#define DMA_QK(cid_, bo_) do { const int cid__ = (cid_); const int boff__ = (bo_); \
      const bf16_t* sq = GQ + ((size_t)cid__ * 4 + hq) * 8192; \
      const bf16_t* sk = GKT + ((size_t)cid__ * 4 + hq) * 8192; \
      const bf16_t* sqk = GQK + ((size_t)cid__ * 8 + hv) * 4096; \
      _Pragma("unroll") for (int i = 0; i < 4; ++i) { const int id = tid + i * 256, r = id >> 4, c = (id & 15) ^ (r & 7); DMA16(sq + r * 128 + c * 8, 16384 + id * 16); } \
      _Pragma("unroll") for (int i = 0; i < 4; ++i) { const int id = tid + i * 256, r = id >> 3, c = (id & 7) ^ (r & 7); DMA16(sk + r * 64 + c * 8, 32768 + id * 16); } \
      _Pragma("unroll") for (int i = 0; i < 2; ++i) { const int id = tid + i * 256, r = id >> 3, c = (id & 7) ^ (r & 7); DMA16(sqk + r * 64 + c * 8, 49152 + id * 16); } } while (0)
    const bool ldr = rb < 128 ? (hh == 1) : true;
    if (ldr) { DMA_WU(cid0, 0); DMA_QK(cid0, 0); DMA_GT(cid0, rb < 128 ? 0 : hh); }
    asm volatile("s_waitcnt vmcnt(0)" ::: "memory");
    __syncthreads();
    for (int n = 0; n < nsteps; ++n) {
      const int tid = VTID, lane = tid & 63, wave = tid >> 6, fr = lane & 15, fq = lane >> 4;
      const int dv0 = half * 64 + wave * 16;
      const int row0 = samp ? MP + b * 16 : (cid0 + n) * 64;
      const int bcur = (rb < 128) ? ((n & 1) << 16) : 0, bnxt = bcur ^ 65536;
      const char* Lw = lbase + bcur; const char* Lq = Lw + 16384; const char* Lk = Lw + 32768; const char* Lqk = Lw + 49152; const char* Lu = Lw + 57344;
      if (n + 1 < nsteps) {
        if (ldr) { DMA_WU(cid0 + n + 1, bnxt); DMA_QK(cid0 + n + 1, bnxt); DMA_GT(cid0 + n + 1, (n + 1) & 1); }
      }
      bf16x8 Sb[4];
#pragma unroll
      for (int c = 0; c < 4; ++c) Sb[c] = mkfrag(S[2 * c], S[2 * c + 1]);
      const float* Lt = (const float*)(lds_all + 131072 + ((rb < 128) ? (n & 1) : hh) * 1024);
      bf16x8 VN[2], VD[2];
      float eg[4][4];
#pragma unroll
      for (int c = 0; c < 2; ++c) { VN[c] = Sb[0]; VD[c] = Sb[0]; }
#pragma unroll
      for (int i = 0; i < 4; ++i)
#pragma unroll
        for (int j = 0; j < 4; ++j) eg[i][j] = 0.f;
      if (act) {
        f32x4 vn[4], vd[4], wsv[4];
        bf16x8 aw[4][4];
        float uu[4][4], gtv[4][4];
#pragma unroll
        for (int i = 0; i < 4; ++i)
#pragma unroll
          for (int c = 0; c < 4; ++c) aw[i][c] = ldfrag(Lw, 256, i * 16 + fr, 4 * c + fq);
#pragma unroll
        for (int i = 0; i < 4; ++i) {
          const uint2 u2 = *(const uint2*)(Lu + ((wave * 4 + i) * 64 + lane) * 8);
          uu[i][0] = __uint_as_float(u2.x << 16); uu[i][1] = __uint_as_float(u2.x & 0xffff0000u);
          uu[i][2] = __uint_as_float(u2.y << 16); uu[i][3] = __uint_as_float(u2.y & 0xffff0000u);
          { const float4 e4 = *(const float4*)(Lt + 64 + i * 16 + 4 * fq), g4 = *(const float4*)(Lt + i * 16 + 4 * fq);
            gtv[i][0] = e4.x; gtv[i][1] = e4.y; gtv[i][2] = e4.z; gtv[i][3] = e4.w;
            eg[i][0] = g4.x; eg[i][1] = g4.y; eg[i][2] = g4.z; eg[i][3] = g4.w; }
        }
#pragma unroll
        for (int i = 0; i < 4; ++i) wsv[i] = (f32x4){0.f, 0.f, 0.f, 0.f};
#pragma unroll
        for (int c = 0; c < 4; ++c)
#pragma unroll
          for (int i = 0; i < 4; ++i) wsv[i] = MFMA16(aw[i][c], Sb[c], wsv[i]);
#pragma unroll
        for (int i = 0; i < 4; ++i) {
          const f32x4 ws_ = wsv[i];
#pragma unroll
          for (int j = 0; j < 4; ++j) {
            const float u = uu[i][j];
            vn[i][j] = u - ws_[j];
            vd[i][j] = vn[i][j] * gtv[i][j];
          }
        }
#pragma unroll
        for (int c = 0; c < 2; ++c) { VN[c] = mkfrag(vn[2 * c], vn[2 * c + 1]); VD[c] = mkfrag(vd[2 * c], vd[2 * c + 1]); }
      }
      if (act) {
#pragma unroll
      for (int ih = 0; ih < 2; ++ih) {
        bf16x8 aq[2][4], aqk[2][2];
        f32x4 qsv[2];
#pragma unroll
        for (int ii = 0; ii < 2; ++ii) {
          const int i = ih * 2 + ii;
#pragma unroll
          for (int c = 0; c < 4; ++c) aq[ii][c] = ldfrag(Lq, 256, i * 16 + fr, 4 * c + fq);
#pragma unroll
          for (int c = 0; c < 2; ++c) aqk[ii][c] = ldfrag(Lqk, 128, i * 16 + fr, 4 * c + fq);
          qsv[ii] = (f32x4){0.f, 0.f, 0.f, 0.f};
        }
#pragma unroll
        for (int c = 0; c < 4; ++c)
#pragma unroll
          for (int ii = 0; ii < 2; ++ii) qsv[ii] = MFMA16(aq[ii][c], Sb[c], qsv[ii]);
#pragma unroll
        for (int ii = 0; ii < 2; ++ii)
#pragma unroll
          for (int j = 0; j < 4; ++j) qsv[ii][j] *= eg[ih * 2 + ii][j];
#pragma unroll
        for (int c = 0; c < 2; ++c)
#pragma unroll
          for (int ii = 0; ii < 2; ++ii) qsv[ii] = MFMA16(aqk[ii][c], VN[c], qsv[ii]);
#pragma unroll
        for (int ii = 0; ii < 2; ++ii)
#pragma unroll
          for (int j = 0; j < 4; ++j) {
            const int t = (ih * 2 + ii) * 16 + 4 * fq + j;
            if (t < tv) O[(size_t)(row0 + t) * D + hv * 128 + dv0 + fr] = f2bf(qsv[ii][j]);
          }
      }
      const float dec = Lt[128];
      {
        bf16x8 ak[8][2];
#pragma unroll
        for (int m = 0; m < 8; ++m) {
#pragma unroll
          for (int c = 0; c < 2; ++c) ak[m][c] = ldfrag(Lk, 128, m * 16 + fr, 4 * c + fq);
          S[m] = S[m] * dec;
        }
#pragma unroll
        for (int c = 0; c < 2; ++c)
#pragma unroll
          for (int m = 0; m < 8; ++m) S[m] = MFMA16(ak[m][c], VD[c], S[m]);
      }
      }
      asm volatile("s_waitcnt vmcnt(0)" ::: "memory");
      __syncthreads();
    }
    float* so = p.out + (samp ? O_GDN_S : O_GDN_P) + ((size_t)b * 8 + hv) * 16384;
    if (act) {
#pragma unroll
    for (int m = 0; m < 8; ++m)
#pragma unroll
      for (int j = 0; j < 4; ++j) so[(m * 16 + 4 * fq + j) * 128 + dv0 + fr] = S[m][j];
    }
  }
}

DI void phase_onorm(const Params& p, const Sub& s) {
  const int lane = VTID & 63, wave = VTID >> 6;
  const bf16_t* O = (const bf16_t*)(p.ws + W_SLOT0);
  const bf16_t* z1 = (const bf16_t*)(p.ws + W_SLOT1);
  bf16_t* on = (bf16_t*)(p.ws + W_SLOT2);
  const int stride = s.vg * 4, rhi = s.samp ? M : MP;
  float gpv[16];
#pragma unroll
  for (int i = 0; i < 16; ++i) gpv[i] = p.gdn_norm_g[(lane & 7) * 16 + i];
  for (int r = (s.samp ? MP : 0) + s.vb * 4 + wave; r < rhi; r += 2 * stride) {
    const bool two = r + stride < rhi;
    const int rr[2] = {r, two ? r + stride : r};
    float v[2][16], zz[2][16];
#pragma unroll
    for (int q = 0; q < 2; ++q) {
      const size_t o = (size_t)rr[q] * D + lane * 16;
#pragma unroll
      for (int i = 0; i < 4; ++i) { ld_bf4(O + o + i * 4, v[q][4 * i], v[q][4 * i + 1], v[q][4 * i + 2], v[q][4 * i + 3]); ld_bf4(z1 + o + i * 4, zz[q][4 * i], zz[q][4 * i + 1], zz[q][4 * i + 2], zz[q][4 * i + 3]); }
    }
#pragma unroll
    for (int q = 0; q < 2; ++q) {
      float ss = 0.f;
#pragma unroll
      for (int i = 0; i < 16; ++i) ss += v[q][i] * v[q][i];
      ss += __shfl_xor(ss, 1); ss += __shfl_xor(ss, 2); ss += __shfl_xor(ss, 4);
      const float rs = rsqrtf(ss * (1.0f / 128.f) + EPS);
      if (q == 0 || two) {
        const size_t o = (size_t)rr[q] * D + lane * 16;
        float w[16];
#pragma unroll
        for (int i = 0; i < 16; ++i) w[i] = v[q][i] * rs * gpv[i] * siluf_(zz[q][i]);
#pragma unroll
        for (int i = 0; i < 4; ++i) st_bf4(on + o + i * 4, w[4 * i], w[4 * i + 1], w[4 * i + 2], w[4 * i + 3]);
      }
    }
  }
}

DI void phase_final(const Params& p, const Sub& s) {
  const int lane = VTID & 63, wave = VTID >> 6;
  const int stride = s.vg * 4, rhi = s.samp ? M : MP;
  for (int r = (s.samp ? MP : 0) + s.vb * 4 + wave; r < rhi; r += 2 * stride) {
    const int rr[2] = {r, (r + stride < rhi) ? r + stride : r};
    const bool two = r + stride < rhi;
    float4 v[2][4], g4[4];
#pragma unroll
    for (int q = 0; q < 2; ++q) {
      const bf16_t* srcb = (const bf16_t*)(p.ws + W_SLOT3) + (size_t)rr[q] * D;
#pragma unroll
      for (int i = 0; i < 4; ++i) ld_bf4(srcb + i * 256 + lane * 4, v[q][i].x, v[q][i].y, v[q][i].z, v[q][i].w);
    }
#pragma unroll
    for (int i = 0; i < 4; ++i) g4[i] = *(const float4*)(p.final_g + i * 256 + lane * 4);
#pragma unroll
    for (int q = 0; q < 2; ++q) {
      float ss = 0.f;
#pragma unroll
      for (int i = 0; i < 4; ++i) ss += v[q][i].x * v[q][i].x + v[q][i].y * v[q][i].y + v[q][i].z * v[q][i].z + v[q][i].w * v[q][i].w;
      ss = wave_sum(ss);
      const float rs = rsqrtf(ss * (1.0f / D) + EPS);
      if (q == 0 || two) {
        float* dstp = p.out + (size_t)rr[q] * D;
#pragma unroll
        for (int i = 0; i < 4; ++i) {
          float4 o; o.x = v[q][i].x * rs * g4[i].x; o.y = v[q][i].y * rs * g4[i].y; o.z = v[q][i].z * rs * g4[i].z; o.w = v[q][i].w * rs * g4[i].w;
          stnt4(dstp + i * 256 + lane * 4, o);
        }
      }
    }
  }
}


#define XB_TMO      128
#define XB_XCNT(j)  (256  + 64 * (j))
#define XB_XSUB(j)  (1280 + 64 * (j))
#define XB_XGEN(j)  (2304 + 64 * (j))
#define XB_TOP      3328
#define XB_TOPGEN   3392
#define XCD_BAR_WORDS 3456
#define XB_SUB 3456
#define XB_SPIN_CAP (1u << 18)
DI unsigned xb_ld(unsigned* p) { return __hip_atomic_load(p, __ATOMIC_RELAXED, __HIP_MEMORY_SCOPE_AGENT); }
DI unsigned xb_add(unsigned* p, unsigned v) { return __hip_atomic_fetch_add(p, v, __ATOMIC_RELAXED, __HIP_MEMORY_SCOPE_AGENT); }
DI unsigned xb_xcc_id() { return (unsigned)__builtin_amdgcn_s_getreg((3 << 11) | 20) & 0xFu; }
#define XB_SPIN(cond, bar) do { unsigned _sp = 0; while (cond) { __builtin_amdgcn_s_sleep(1); \
    if ((++_sp & 255u) == 0u) { if (xb_ld(&(bar)[XB_TMO])) break; if (_sp > XB_SPIN_CAP) { atomicAdd(&(bar)[XB_TMO], 1u); break; } } } } while (0)
struct XcdBarrier { unsigned* bar; unsigned x; volatile LAS unsigned* st; };
DI XcdBarrier xcd_barrier_post(unsigned* bar, volatile LAS unsigned* st) {
  XcdBarrier b; b.bar = bar; b.x = xb_xcc_id(); b.st = st;
  if (threadIdx.x == 0) (void)xb_add(&bar[XB_XCNT(b.x)], 1u);
  return b;
}
DI void xcd_barrier_complete(unsigned* bar, unsigned x, unsigned& nloc, unsigned& nx) {
  const unsigned G = gridDim.x * gridDim.y * gridDim.z;
  unsigned sum, cnt, mine, sp = 0u;
  for (;;) {
    sum = 0u; cnt = 0u; mine = 0u;
#pragma unroll
    for (unsigned j = 0; j < 16; ++j) { const unsigned c = xb_ld(&bar[XB_XCNT(j)]); sum += c; cnt += (c > 0u) ? 1u : 0u; mine = (j == x) ? c : mine; }
    if (sum == G) break;
    __builtin_amdgcn_s_sleep(1);
    if ((++sp & 255u) == 0u) { if (xb_ld(&bar[XB_TMO])) break; if (sp > XB_SPIN_CAP) { atomicAdd(&bar[XB_TMO], 1u); break; } }
  }
  nloc = mine > 0u ? mine : 1u; nx = cnt > 0u ? cnt : 1u;
}
DI void xcd_barrier(const XcdBarrier& b) {
  asm volatile("s_waitcnt vmcnt(0)" ::: "memory");
  __syncthreads();
  if (threadIdx.x == 0) {
    unsigned* bar = b.bar;
    __builtin_amdgcn_s_waitcnt(0);
    unsigned nloc = b.st[0], nx = b.st[1];
    if (nloc == 0u) { xcd_barrier_complete(bar, b.x, nloc, nx); b.st[0] = nloc; b.st[1] = nx; }
    const unsigned old = xb_add(&bar[XB_XSUB(b.x)], 1u);
    const unsigned gen = old / nloc;
    if (old + 1u == (gen + 1u) * nloc) {
      __builtin_amdgcn_fence(__ATOMIC_RELEASE, "agent");
      asm volatile("s_waitcnt vmcnt(0)" ::: "memory");
      const unsigned og = xb_add(&bar[XB_TOP], 1u);
      const unsigned tg = og / nx;
      if (og + 1u == (tg + 1u) * nx) xb_add(&bar[XB_TOPGEN], 1u);
      else XB_SPIN(xb_ld(&bar[XB_TOPGEN]) == tg, bar);
      __builtin_amdgcn_fence(__ATOMIC_ACQUIRE, "agent");
      xb_add(&bar[XB_XGEN(b.x)], 1u);
      asm volatile("s_waitcnt vmcnt(0)" ::: "memory");
    } else {
      XB_SPIN(xb_ld(&bar[XB_XGEN(b.x)]) == gen, bar);
      __builtin_amdgcn_fence(__ATOMIC_ACQUIRE, "agent");
      asm volatile("s_waitcnt vmcnt(0)" ::: "memory");
    }
  }
  __syncthreads();
}

#define AS4 __attribute__((address_space(4)))
DI void load_params(Params& q) {
#if defined(__HIP_DEVICE_COMPILE__)
  int off = 0; asm volatile("" : "+s"(off));
  q = *(const Params AS4*)((const char AS4*)__builtin_amdgcn_kernarg_segment_ptr() + off);
#endif
}
DI void sub_barrier(unsigned* bar, unsigned target) {
  asm volatile("s_waitcnt vmcnt(0)" ::: "memory");
  __syncthreads();
  if (threadIdx.x == 0) {
    __builtin_amdgcn_fence(__ATOMIC_RELEASE, "agent");
    asm volatile("s_waitcnt vmcnt(0)" ::: "memory");
    xb_add(&bar[XB_SUB], 1u);
    XB_SPIN(xb_ld(&bar[XB_SUB]) < target, bar);
    __builtin_amdgcn_fence(__ATOMIC_ACQUIRE, "agent");
    asm volatile("s_waitcnt vmcnt(0)" ::: "memory");
  }
  __syncthreads();
}

__global__ void __launch_bounds__(512, 1) fwd_megakernel(Params p) {
  __shared__ __attribute__((aligned(16))) char lds_all[LDS_BYTES];
#define lds (lds_all + ((otid() >> 8) << 16))
  cg::grid_group grid = cg::this_grid();
  __shared__ uint4 xb_words;
  if (threadIdx.x == 0) xb_words = make_uint4(0u, 0u, 0u, 0u);
  __syncthreads();
  { Params q; load_params(q); (void)xcd_barrier_post((unsigned*)(q.ws + W_BAR), (volatile LAS unsigned*)&xb_words); }
#define GSYNC() do { Params q_; load_params(q_); XcdBarrier b_; b_.bar = (unsigned*)(q_.ws + W_BAR); b_.x = xb_xcc_id(); b_.st = (volatile LAS unsigned*)&xb_words; xcd_barrier(b_); } while (0)
#define PSUB Sub{VBID, VGRID, false}
  if (gridDim.x > 65535u) grid.sync();
  for (int rep = 0; rep < REP_SETUP; ++rep) { { Params q; load_params(q); phase_setup(q, lds); } GSYNC(); }
  { Params q; load_params(q); phase_norm_mod(q, PSUB, 0, false, (bf16_t*)(q.ws + W_SLOT0)); phase_norm_mod(q, Sub{VBID, VGRID, true}, 0, false, (bf16_t*)(q.ws + W_SLOT0)); }
  GSYNC();
  for (int rep = 0; rep < REP_GEMM; ++rep) { { Params q; load_params(q); phase_g1(q, PSUB, lds_all); } GSYNC(); }
  for (int rep = 0; rep < REP_S5; ++rep) {
    { Params q; load_params(q); phase_s5_e(q, lds); }
    GSYNC();
    { Params q; load_params(q); phase_s5_scan(q); }
    GSYNC();
    { Params q; load_params(q); phase_s5_y(q, lds); }
    GSYNC();
  }
  for (int rep = 0; rep < REP_GEMM; ++rep) { { Params q; load_params(q); phase_g2(q, PSUB, lds_all); } GSYNC(); }
  for (int rep = 0; rep < REP_GEMM; ++rep) { { Params q; load_params(q); phase_gout(q, PSUB, lds_all, 0, (const bf16_t*)(q.ws + W_SLOT0), (const bf16_t*)(q.ws + W_S5OUT)); } GSYNC(); }
  { Params q; load_params(q); phase_norm_mod(q, PSUB, 1, true, (bf16_t*)(q.ws + W_SLOT0)); }
  GSYNC();
  for (int rep = 0; rep < REP_GEMM; ++rep) { { Params q; load_params(q); phase_g4(q, PSUB, lds_all); } GSYNC(); }
  for (int rep = 0; rep < REP_PREP; ++rep) { { Params q; load_params(q); phase_gdn_prep(q, PSUB, lds); } GSYNC(); }
  if (blockIdx.x < 128) {
    { Params q; load_params(q); phase_gdn_seq(q, Sub{0, 0, false}, lds_all); }
  } else {
    const int svb = (blockIdx.x - 128) * 2 + (otid() >> 8);
    unsigned tgt = 0;
#define SSUB Sub{svb, 256, true}
#define SSYNC() do { Params q_; load_params(q_); tgt += gridDim.x - 128; sub_barrier((unsigned*)(q_.ws + W_BAR), tgt); } while (0)
    { Params q; load_params(q); phase_g1(q, SSUB, lds_all); }
    SSYNC();
    { Params q; load_params(q); phase_s5_sample(q, SSUB); }
    SSYNC();
    { Params q; load_params(q); phase_g2(q, SSUB, lds_all); }
    SSYNC();
    { Params q; load_params(q); phase_gout(q, SSUB, lds_all, 0, (const bf16_t*)(q.ws + W_SLOT0), (const bf16_t*)(q.ws + W_S5OUT)); }
    SSYNC();
    { Params q; load_params(q); phase_norm_mod(q, SSUB, 1, true, (bf16_t*)(q.ws + W_SLOT0)); }
    SSYNC();
    { Params q; load_params(q); phase_g4(q, SSUB, lds_all); }
    SSYNC();
    { Params q; load_params(q); phase_gdn_prep(q, SSUB, lds); }
    SSYNC();
    { Params q; load_params(q); phase_gdn_seq(q, SSUB, lds_all); }
    SSYNC();
    { Params q; load_params(q); phase_onorm(q, SSUB); }
    SSYNC();
    { Params q; load_params(q); phase_gout(q, SSUB, lds_all, 1, (const bf16_t*)(q.ws + W_SLOT2), (const bf16_t*)(q.ws + W_GDNOUT)); }
  }
  GSYNC();
  { Params q; load_params(q); phase_onorm(q, PSUB); }
  GSYNC();
  { Params q; load_params(q); phase_gout(q, PSUB, lds_all, 1, (const bf16_t*)(q.ws + W_SLOT2), (const bf16_t*)(q.ws + W_GDNOUT)); }
  GSYNC();
  { Params q; load_params(q); phase_final(q, PSUB); phase_final(q, Sub{VBID, VGRID, true}); }
#undef lds
}

extern "C" void kernel_launch(void* const* d_in, const int* in_sizes, int n_in, void* d_out, int out_size, void* d_ws, size_t ws_size,
                              hipStream_t stream) {
  static int grid_blocks = 0;
  if (!grid_blocks) {
    int dev = 0, cus = 0, per_cu = 0;
    hipGetDevice(&dev);
    hipDeviceGetAttribute(&cus, hipDeviceAttributeMultiprocessorCount, dev);
    hipOccupancyMaxActiveBlocksPerMultiprocessor(&per_cu, fwd_megakernel, 512, 0);
    if (per_cu > 1) per_cu = 1;
    if (per_cu < 1) per_cu = 1;
    grid_blocks = cus * per_cu;
    grid_blocks &= ~7;
  }
  Params p{};
  const float** pp = (const float**)&p;
  for (int i = 0; i < 30; ++i) pp[i] = (const float*)d_in[i];
  p.out = (float*)d_out;
  p.ws = (char*)d_ws;
  hipMemsetAsync((char*)d_ws + W_BAR, 0, (XCD_BAR_WORDS + 64) * 4, stream);
  void* args[] = {&p};
  hipError_t e = hipLaunchCooperativeKernel((void*)fwd_megakernel, dim3(grid_blocks), dim3(512), args, 0, stream);
  if (e != hipSuccess) fprintf(stderr, "cooperative launch failed: %s (grid %d)\n", hipGetErrorString(e), grid_blocks);
}
```

```cpp
#include <hip/hip_runtime.h>
#include <hip/hip_cooperative_groups.h>
#include <cstdio>
namespace cg = cooperative_groups;

typedef unsigned short bf16_t;
typedef short bf16x8 __attribute__((ext_vector_type(8)));
typedef float f32x4 __attribute__((ext_vector_type(4)));
#define DI __device__ __forceinline__

constexpr int D = 1024;
constexpr int MP = 65536;
constexpr int MS = 256;
constexpr int M = MP + MS;
constexpr int NCH = 1040;
constexpr float EPS = 1e-6f;
constexpr int LDS_BYTES = 128 * 1024 + 2048;
#define REP_SETUP 1
#define REP_GEMM 1
#define REP_S5 1
#define REP_PREP 1
#define REP_SEQ 1

constexpr size_t O_Y = 0;
constexpr size_t O_S5RE_P = 67371008;
constexpr size_t O_S5IM_P = 67403776;
constexpr size_t O_GDN_P = 67436544;
constexpr size_t O_CONV_P = 68485120;
constexpr size_t O_S5RE_S = 68534272;
constexpr size_t O_S5IM_S = 68599808;
constexpr size_t O_GDN_S = 68665344;
constexpr size_t O_CONV_S = 70762496;

constexpr size_t MU = (size_t)M * 1024 * 2;
constexpr size_t W_S5IN = 0;
constexpr size_t W_GLU = 4194304;
constexpr size_t W_S5OUT = 6291456;
constexpr size_t W_GDNIN = 8388608;
constexpr size_t W_GDNOUT = 15204352;
constexpr size_t W_MOD = 17301504;
constexpr size_t W_BA = 17891328;
constexpr size_t W_USAMP = 22102016;
constexpr size_t W_ABAR = 23150592;
constexpr size_t W_A64 = 23183360;
constexpr size_t W_BBAR = 23216128;
constexpr size_t W_ZERO = 23740416;
constexpr size_t W_BAR = 23740672;
constexpr size_t W_SLOT0 = 25165824;
constexpr size_t W_SLOT1 = W_SLOT0 + MU;
constexpr size_t W_SLOT2 = W_SLOT1 + MU;
constexpr size_t W_SLOT3 = W_SLOT2 + MU;
constexpr size_t W_X = W_SLOT3 + MU;
constexpr size_t W_KTAB = W_X;
constexpr size_t W_ME = W_KTAB + 2097152;
constexpr size_t W_MC = W_ME + 16777216;
constexpr size_t W_E = W_MC + 16777216;
constexpr size_t W_H = W_E + 67108864;
constexpr size_t W_GW = W_X;
constexpr size_t W_GU = W_GW + (size_t)NCH * 8 * 64 * 128 * 2;
constexpr size_t W_GQK = W_GU + (size_t)NCH * 8 * 64 * 128 * 2;
constexpr size_t W_GQ = W_GQK + (size_t)NCH * 8 * 64 * 64 * 2;
constexpr size_t W_GKT = W_GQ + (size_t)NCH * 4 * 64 * 128 * 2;
constexpr size_t W_GGC = W_GKT + (size_t)NCH * 4 * 64 * 128 * 2;

struct Params {
  const float* x_prompt; const float* x_sample; const float* c_prompt; const float* c_sample;
  const float* st_s5_re; const float* st_s5_im; const float* st_gdn; const float* st_conv;
  const float* norm_g; const float* w_ada; const float* b_ada; const float* s5_w_in;
  const float* s5_log_step; const float* s5_lam_re; const float* s5_lam_im; const float* s5_b_re;
  const float* s5_b_im; const float* s5_c_re; const float* s5_c_im; const float* s5_d;
  const float* s5_w_glu; const float* s5_b_glu; const float* s5_w_out; const float* gdn_w_in;
  const float* gdn_conv_w; const float* gdn_a_log; const float* gdn_dt_bias; const float* gdn_norm_g;
  const float* gdn_w_out; const float* final_g;
  float* out; char* ws;
};

DI int otid() { int t = threadIdx.x; asm volatile("" : "+v"(t)); return t; }
#define VTID (otid() & 255)
#define VBID ((int)(blockIdx.x * 2 + (otid() >> 8)))
#define VGRID ((int)(gridDim.x * 2))
typedef __bf16 hwbf16x2 __attribute__((ext_vector_type(2)));
typedef float hwf32x2 __attribute__((ext_vector_type(2)));
DI bf16_t f2bf(float f) { const __bf16 r = (__bf16)f; return __builtin_bit_cast(bf16_t, r); }
DI float bf2f(bf16_t h) { return __uint_as_float(((unsigned)h) << 16); }
DI unsigned pack2(float a, float b) { const hwf32x2 v = {a, b}; const hwbf16x2 r = __builtin_convertvector(v, hwbf16x2); return __builtin_bit_cast(unsigned, r); }
DI float sigmoidf_(float x) { return __builtin_amdgcn_rcpf(1.0f + __expf(-x)); }
DI float siluf_(float x) { return x * sigmoidf_(x); }
DI float geluf_(float x) { return x * sigmoidf_(1.5957691216057308f * (x + 0.044715f * x * x * x)); }
DI float row16_sum(float v) {
  v += __int_as_float(__builtin_amdgcn_update_dpp(0, __float_as_int(v), 0xB1, 0xF, 0xF, true));
  v += __int_as_float(__builtin_amdgcn_update_dpp(0, __float_as_int(v), 0x4E, 0xF, 0xF, true));
  v += __int_as_float(__builtin_amdgcn_update_dpp(0, __float_as_int(v), 0x141, 0xF, 0xF, true));
  v += __int_as_float(__builtin_amdgcn_update_dpp(0, __float_as_int(v), 0x140, 0xF, 0xF, true));
  return v;
}
DI float wave_sum(float v) {
  v = row16_sum(v);
  v += __shfl_xor(v, 16); v += __shfl_xor(v, 32);
  return v;
}
DI int row_bi(int r) { return r < MP ? (r >> 13) : 8 + ((r - MP) >> 4); }
DI const float* xrow(const Params& p, int r) { return r < MP ? p.x_prompt + (size_t)r * D : p.x_sample + (size_t)(r - MP) * D; }
DI bf16x8 mkfrag(f32x4 a, f32x4 b) {
  typedef unsigned u32x4 __attribute__((ext_vector_type(4)));
  u32x4 v; v[0] = pack2(a[0], a[1]); v[1] = pack2(a[2], a[3]); v[2] = pack2(b[0], b[1]); v[3] = pack2(b[2], b[3]);
  return __builtin_bit_cast(bf16x8, v);
}
DI void lds_barrier() { asm volatile("s_waitcnt lgkmcnt(0)" ::: "memory"); __builtin_amdgcn_s_barrier(); asm volatile("" ::: "memory"); }
#define MFMA16(a, b, c) __builtin_amdgcn_mfma_f32_16x16x32_bf16((a), (b), (c), 0, 0, 0)

DI bf16x8 ldfrag(const char* base, int rowbytes, int row, int chunk) {
  return *(const bf16x8*)(base + row * rowbytes + ((chunk ^ (row & 7)) << 4));
}
DI bf16x8 ldfrag_perm(const char* base, int rowbytes, int row, int c, int fq) {
  typedef unsigned u32x2 __attribute__((ext_vector_type(2)));
  typedef unsigned u32x4 __attribute__((ext_vector_type(4)));
  const int ch0 = 4 * c + (fq >> 1), ch1 = ch0 + 2, off = (fq & 1) * 8;
  const u32x2 lo = *(const u32x2*)(base + row * rowbytes + ((ch0 ^ (row & 7)) << 4) + off);
  const u32x2 hi = *(const u32x2*)(base + row * rowbytes + ((ch1 ^ (row & 7)) << 4) + off);
  u32x4 v; v[0] = lo[0]; v[1] = lo[1]; v[2] = hi[0]; v[3] = hi[1];
  return __builtin_bit_cast(bf16x8, v);
}

DI int kperm(int k) { const int ki = k & 31; return (k & ~31) + ((ki & 15) >> 2) * 8 + (ki >> 4) * 4 + (ki & 3); }
DI int tile_remap(int L, int nt) {
  const int q = nt >> 3, r = nt & 7, xcd = L & 7, off = L >> 3;
  return (xcd < r ? xcd * (q + 1) : r * (q + 1) + (xcd - r) * q) + off;
}

#define LAS __attribute__((address_space(3)))
struct NoLoad {};
struct LdY { uint2 u; float4 d; };
template <class FA, class FB, class FL, class FS>
DI void gemm_tile(char* lds, int ksteps, int rot, FA fa, FB fb, FL fl, FS fs) {
  const int tid = VTID, lane = tid & 63, wave = tid >> 6;
  const int wr = wave >> 1, wc = wave & 1, fr = lane & 15, fq = lane >> 4;
  f32x4 acc[4][4];
#pragma unroll
  for (int m = 0; m < 4; ++m)
#pragma unroll
    for (int n = 0; n < 4; ++n) acc[m][n] = (f32x4){0.f, 0.f, 0.f, 0.f};
  LAS char* l3 = (LAS char*)lds;
#pragma unroll
  for (int i = 0; i < 4; ++i) {
    const int id = tid + i * 256, r = id >> 3, c = (id & 7) ^ (r & 7);
    __builtin_amdgcn_global_load_lds((const unsigned*)fa(r, rot * 8 + c), (LAS unsigned*)(l3 + id * 16), 16, 0, 0);
    __builtin_amdgcn_global_load_lds((const unsigned*)fb(r, rot * 8 + c), (LAS unsigned*)(l3 + 16384 + id * 16), 16, 0, 0);
  }
  asm volatile("s_waitcnt vmcnt(0)" ::: "memory");
  __syncthreads();
  for (int ks = 0; ks < ksteps; ++ks) {
    const int cur = ks & 1;
    if (ks + 1 < ksteps) {
      int kn = ks + 1 + rot; if (kn >= ksteps) kn -= ksteps;
      LAS char* dst = l3 + (cur ^ 1) * 32768;
#pragma unroll
      for (int i = 0; i < 4; ++i) {
        const int id = tid + i * 256, r = id >> 3, c = (id & 7) ^ (r & 7);
        __builtin_amdgcn_global_load_lds((const unsigned*)fa(r, kn * 8 + c), (LAS unsigned*)(dst + id * 16), 16, 0, 0);
        __builtin_amdgcn_global_load_lds((const unsigned*)fb(r, kn * 8 + c), (LAS unsigned*)(dst + 16384 + id * 16), 16, 0, 0);
      }
    }
    const char* A = lds + cur * 32768;
    const char* B = A + 16384;
#pragma unroll
    for (int kk = 0; kk < 2; ++kk) {
      bf16x8 af[4], bq[4];
#pragma unroll
      for (int m = 0; m < 4; ++m) af[m] = ldfrag(A, 128, wr * 64 + m * 16 + fr, kk * 4 + fq);
#pragma unroll
      for (int n = 0; n < 4; ++n) bq[n] = ldfrag(B, 128, wc * 64 + n * 16 + fr, kk * 4 + fq);
#pragma unroll
      for (int m = 0; m < 4; ++m)
#pragma unroll
        for (int n = 0; n < 4; ++n) acc[m][n] = MFMA16(bq[n], af[m], acc[m][n]);
    }
    asm volatile("s_waitcnt vmcnt(0)" ::: "memory");
    __syncthreads();
  }
  decltype(fl(0, 0)) ld[4][4];
#pragma unroll
  for (int m = 0; m < 4; ++m)
#pragma unroll
    for (int n = 0; n < 4; ++n) ld[m][n] = fl(wr * 64 + m * 16 + fr, wc * 64 + n * 16 + 4 * fq);
#pragma unroll
  for (int m = 0; m < 4; ++m)
#pragma unroll
    for (int n = 0; n < 4; ++n) fs(wr * 64 + m * 16 + fr, wc * 64 + n * 16 + 4 * fq, acc[m][n], ld[m][n]);
}
template <class FA, class FB, class FE>
DI void gemm_tile(char* lds, int ksteps, int rot, FA fa, FB fb, FE fe) {
  gemm_tile(lds, ksteps, rot, fa, fb, [](int, int) { return NoLoad{}; }, [&](int r, int c, f32x4 v, const NoLoad&) { fe(r, c, v); });
}

DI int lds_byte8(int r, int c) { const int st = (r >> 4) * 2 + (c >> 5), rr = r & 15, cc = c & 31, ob = rr * 64 + cc * 2; return st * 1024 + (ob ^ (((ob >> 9) & 1) << 5)); }
DI void stage_rc8(int b, int& R, int& C) { const int st = b / 1024, sb = b % 1024, swz = sb ^ (((sb >> 9) & 1) << 5); R = (st >> 1) * 16 + swz / 64; C = (st & 1) * 32 + (swz % 64) / 2; }
struct Ld2 { float4 a, b; };
template <class FL, class FS>
DI void gemm8_tile(char* shmc, const bf16_t* __restrict__ A, const bf16_t* __restrict__ Bt, const int K, const int brow, const int bcol, FL fl, FS fs) {
  constexpr int HT = 8192, HALF = 128;
  bf16_t* shm = (bf16_t*)shmc;
#define SA(b, h) (shm + ((b) * 2 + (h)) * HT)
#define SB(b, h) (shm + (4 + (b) * 2 + (h)) * HT)
#define STAGE(P, BASE, br, kt) do { const long _g = (long)(br) * K + (long)(kt) * 64; \
    _Pragma("unroll") for (int _i = 0; _i < 2; ++_i) { const int _b = tidx * 16 + _i * 8192; int _r, _c; stage_rc8(_b, _r, _c); \
      __builtin_amdgcn_global_load_lds((const unsigned*)(BASE + _g + (long)_r * K + _c), (LAS unsigned*)((LAS char*)(P) + _b), 16, 0, 0); } } while (0)
#define LDA(dst, b, h) _Pragma("unroll") for (int m = 0; m < 4; ++m) _Pragma("unroll") for (int k = 0; k < 2; ++k) \
    dst[m][k] = *reinterpret_cast<const bf16x8*>((const char*)SA(b, h) + lds_byte8(wr * 64 + m * 16 + fr, k * 32 + fq * 8))
#define LDB(dst, b, h) _Pragma("unroll") for (int n = 0; n < 2; ++n) _Pragma("unroll") for (int k = 0; k < 2; ++k) \
    dst[n][k] = *reinterpret_cast<const bf16x8*>((const char*)SB(b, h) + lds_byte8(wc * 32 + n * 16 + fr, k * 32 + fq * 8))
#define MMA(ai, bj, At_, Bt_) do { __builtin_amdgcn_s_setprio(1); \
    _Pragma("unroll") for (int m = 0; m < 4; ++m) _Pragma("unroll") for (int n = 0; n < 2; ++n) _Pragma("unroll") for (int k = 0; k < 2; ++k) \
      acc[ai][bj][m][n] = MFMA16(Bt_[n][k], At_[m][k], acc[ai][bj][m][n]); \
    __builtin_amdgcn_s_setprio(0); } while (0)
#define WAIT_V(n) asm volatile("s_waitcnt vmcnt(" #n ")" ::: "memory")
#define WAIT_L(n) asm volatile("s_waitcnt lgkmcnt(" #n ")" ::: "memory")
#define BAR __builtin_amdgcn_s_barrier()
#define SCHED __builtin_amdgcn_sched_barrier(0)
  const int tidx = otid();
  const int wid = tidx >> 6, lane = tidx & 63, wr = wid >> 2, wc = wid & 3, fr = lane & 15, fq = lane >> 4;
  f32x4 acc[2][2][4][2];
#pragma unroll
  for (int a = 0; a < 2; ++a)
#pragma unroll
    for (int b = 0; b < 2; ++b)
#pragma unroll
      for (int m = 0; m < 4; ++m)
#pragma unroll
        for (int n = 0; n < 2; ++n) acc[a][b][m][n] = (f32x4){0.f, 0.f, 0.f, 0.f};
  bf16x8 At[4][2], B0[2][2], B1[2][2];
  const int nt = K / 64;
  STAGE(SB(0, 0), Bt, bcol, 0); STAGE(SA(0, 0), A, brow, 0);
  STAGE(SB(0, 1), Bt, bcol + HALF, 0); STAGE(SA(0, 1), A, brow + HALF, 0);
  if (wr == 1) BAR;
  WAIT_V(4); BAR;
  STAGE(SB(1, 0), Bt, bcol, 1); STAGE(SA(1, 0), A, brow, 1); STAGE(SB(1, 1), Bt, bcol + HALF, 1);
  WAIT_V(6); BAR;
  for (int t = 0; t < nt - 2; t += 2) {
    LDB(B0, 0, 0); SCHED; LDA(At, 0, 0); STAGE(SA(1, 1), A, brow + HALF, t + 1);
    WAIT_L(8); BAR; WAIT_L(0); MMA(0, 0, At, B0); BAR; SCHED;
    LDB(B1, 0, 1); STAGE(SB(0, 0), Bt, bcol, t + 2);
    BAR; WAIT_L(0); MMA(0, 1, At, B1); BAR;
    LDA(At, 0, 1); STAGE(SA(0, 0), A, brow, t + 2);
    BAR; WAIT_L(0); MMA(1, 0, At, B0); BAR; SCHED;
    STAGE(SB(0, 1), Bt, bcol + HALF, t + 2);
    WAIT_V(6); BAR; MMA(1, 1, At, B1); BAR;
    LDB(B0, 1, 0); SCHED; LDA(At, 1, 0); STAGE(SA(0, 1), A, brow + HALF, t + 2);
    WAIT_L(8); BAR; WAIT_L(0); MMA(0, 0, At, B0); BAR; SCHED;
    LDB(B1, 1, 1); STAGE(SB(1, 0), Bt, bcol, t + 3);
    BAR; WAIT_L(0); MMA(0, 1, At, B1); BAR;
    LDA(At, 1, 1); STAGE(SA(1, 0), A, brow, t + 3);
    BAR; WAIT_L(0); MMA(1, 0, At, B0); BAR; SCHED;
    STAGE(SB(1, 1), Bt, bcol + HALF, t + 3);
    WAIT_V(6); BAR; MMA(1, 1, At, B1); BAR;
  }
  { LDB(B0, 0, 0); LDA(At, 0, 0); STAGE(SA(1, 1), A, brow + HALF, nt - 1);
    BAR; WAIT_L(0); MMA(0, 0, At, B0); BAR;
    LDB(B1, 0, 1); BAR; WAIT_L(0); MMA(0, 1, At, B1); BAR;
    LDA(At, 0, 1); WAIT_V(4); BAR; WAIT_L(0); MMA(1, 0, At, B0); MMA(1, 1, At, B1); BAR; }
  { LDB(B0, 1, 0); LDA(At, 1, 0); WAIT_V(2); BAR; WAIT_L(0); MMA(0, 0, At, B0); BAR;
    LDB(B1, 1, 1); WAIT_V(0); BAR; WAIT_L(0); MMA(0, 1, At, B1); BAR;
    LDA(At, 1, 1); BAR; WAIT_L(0); MMA(1, 0, At, B0); MMA(1, 1, At, B1); BAR; }
  if (wr == 0) BAR;
#pragma unroll
  for (int ai = 0; ai < 2; ++ai)
#pragma unroll
    for (int mh = 0; mh < 2; ++mh) {
      decltype(fl(0, 0)) ld[2][2][2];
#pragma unroll
      for (int mm = 0; mm < 2; ++mm)
#pragma unroll
        for (int bj = 0; bj < 2; ++bj)
#pragma unroll
          for (int n = 0; n < 2; ++n) ld[mm][bj][n] = fl(brow + ai * HALF + wr * 64 + (2 * mh + mm) * 16 + fr, bcol + bj * HALF + wc * 32 + n * 16 + 4 * fq);
#pragma unroll
      for (int mm = 0; mm < 2; ++mm)
#pragma unroll
        for (int bj = 0; bj < 2; ++bj)
#pragma unroll
          for (int n = 0; n < 2; ++n) fs(brow + ai * HALF + wr * 64 + (2 * mh + mm) * 16 + fr, bcol + bj * HALF + wc * 32 + n * 16 + 4 * fq, acc[ai][bj][2 * mh + mm][n], ld[mm][bj][n]);
    }
  asm volatile("s_waitcnt vmcnt(0)" ::: "memory");
  __syncthreads();
#undef SA
#undef SB
#undef STAGE
#undef LDA
#undef LDB
#undef MMA
}
DI void tile8_order(int L, int nM, int nN, int& pm, int& pn) {
  const int t = tile_remap(L, nM * nN), nig = 8 * nN, gid = t / nig, fm = gid * 8, gsz = (nM - fm) < 8 ? (nM - fm) : 8;
  pm = fm + ((t % nig) % gsz); pn = (t % nig) / gsz;
}

DI void st_bf4(bf16_t* p, float a, float b, float c, float d) { uint2 v; v.x = pack2(a, b); v.y = pack2(c, d); *(uint2*)p = v; }
DI void ld_bf4(const bf16_t* p, float& a, float& b, float& c, float& d) {
  const uint2 v = *(const uint2*)p; a = __uint_as_float(v.x << 16); b = __uint_as_float(v.x & 0xffff0000u); c = __uint_as_float(v.y << 16); d = __uint_as_float(v.y & 0xffff0000u);
}

struct Sub { int vb, vg; bool samp; };
template <class FL, class FS>
DI void gemm_dispatch(const Sub& s, char* lds_all, const bf16_t* A, const bf16_t* Bt, const int nN256, FL fl, FS fs) {
  if (!s.samp) {
    const int nM = 256;
    for (int L = blockIdx.x; L < nM * nN256; L += gridDim.x) {
      int pm, pn; tile8_order(L, nM, nN256, pm, pn);
      gemm8_tile(lds_all, A, Bt, D, pm * 256, pn * 256, fl, fs);
    }
  } else {
    char* ldsh = lds_all + ((otid() >> 8) << 16);
    const int nN = nN256 * 2, nt = 2 * nN;
    for (int k_ = 0; k_ * s.vg < nt; ++k_) {
      int t = k_ * s.vg + s.vb;
      if (k_ * s.vg + (s.vb & ~1) >= nt) continue;
      if (t >= nt) t = nt - 1;
      const int row0 = MP + (t / nN) * 128, col0 = (t % nN) * 128;
      gemm_tile(ldsh, 16, 0,
        [&](int r, int kc) { return A + (size_t)(row0 + r) * D + kc * 8; },
        [&](int n, int kc) { return Bt + (size_t)(col0 + n) * D + kc * 8; },
        [&](int r, int c, f32x4 v) { fs(row0 + r, col0 + c, v, fl(row0 + r, col0 + c)); });
    }
  }
}

DI void phase_setup(const Params& p, char* lds) {
  const int tid = VTID;
  if (VBID == 0 && tid < 16) ((unsigned*)(p.ws + W_ZERO))[tid] = 0u;
  const int NITEM = 384 + 2112 + 256;
  for (int k_ = 0; k_ * VGRID < (NITEM); ++k_) {
    int it = k_ * VGRID + VBID; const bool active_ = it < (NITEM); if (!active_) it = (NITEM) - 1;
    if (it < 384) {
      const int layer = it / 192, cc = it % 192, col = tid & 15, kp = tid >> 4;
      float* cs = (float*)lds;
      float acc[24];
#pragma unroll
      for (int i = 0; i < 24; ++i) acc[i] = 0.f;
      for (int kh = 0; kh < 2; ++kh) {
        __syncthreads();
        for (int idx = tid; idx < 24 * 512; idx += 256) {
          const int bi = idx >> 9, k = kh * 512 + (idx & 511);
          const float c = bi < 8 ? p.c_prompt[bi * D + k] : p.c_sample[(bi - 8) * D + k];
          cs[idx] = c / (1.0f + expf(-c));
        }
        __syncthreads();
        const float* wp = p.w_ada + ((size_t)layer * D + kh * 512 + kp * 32) * 3072 + cc * 16 + col;
#pragma unroll
        for (int k8 = 0; k8 < 32; k8 += 8) {
          float w[8];
#pragma unroll
          for (int u = 0; u < 8; ++u) w[u] = wp[(size_t)(k8 + u) * 3072];
#pragma unroll
          for (int bi = 0; bi < 24; ++bi) {
            const float4 c0 = *(const float4*)(cs + bi * 512 + kp * 32 + k8), c1 = *(const float4*)(cs + bi * 512 + kp * 32 + k8 + 4);
            acc[bi] += c0.x * w[0] + c0.y * w[1] + c0.z * w[2] + c0.w * w[3] + c1.x * w[4] + c1.y * w[5] + c1.z * w[6] + c1.w * w[7];
          }
        }
      }
      __syncthreads();
      float* red = (float*)lds;
#pragma unroll
      for (int bi = 0; bi < 24; ++bi) red[(kp * 24 + bi) * 16 + col] = acc[bi];
      __syncthreads();
      float* mod = (float*)(p.ws + W_MOD);
      for (int idx = tid; idx < 24 * 16; idx += 256) {
        const int bi = idx >> 4, c2 = idx & 15;
        float s = 0.f;
#pragma unroll
        for (int q = 0; q < 16; ++q) s += red[(q * 24 + bi) * 16 + c2];
        mod[(size_t)(bi * 2 + layer) * 3072 + cc * 16 + c2] = s + p.b_ada[layer * 3072 + cc * 16 + c2];
      }
      __syncthreads();
    } else if (it < 384 + 2112) {
      int t = it - 384;
      const float* W; bf16_t* Wt; int N, ntn;
      if (t < 512) { W = p.s5_w_in; Wt = (bf16_t*)(p.ws + W_S5IN); N = 2048; ntn = 32; }
      else if (t < 768) { t -= 512; W = p.s5_w_glu; Wt = (bf16_t*)(p.ws + W_GLU); N = 1024; ntn = 16; }
      else if (t < 1024) { t -= 768; W = p.s5_w_out; Wt = (bf16_t*)(p.ws + W_S5OUT); N = 1024; ntn = 16; }
      else if (t < 1856) { t -= 1024; W = p.gdn_w_in; Wt = (bf16_t*)(p.ws + W_GDNIN); N = 3088; ntn = 52; }
      else { t -= 1856; W = p.gdn_w_out; Wt = (bf16_t*)(p.ws + W_GDNOUT); N = 1024; ntn = 16; }
      const int tk = t / ntn, tn = t % ntn, k0 = tk * 64, n0 = tn * 64;
      float* tl = (float*)lds;
      const int tx = tid & 63, ty = tid >> 6;
#pragma unroll 4
      for (int i = 0; i < 16; ++i) {
        const int k = k0 + ty * 16 + i, n = n0 + tx;
        tl[(ty * 16 + i) * 65 + tx] = (n < N) ? W[(size_t)k * N + n] : 0.f;
      }
      __syncthreads();
#pragma unroll 4
      for (int i = 0; i < 16; ++i) {
        const int n = n0 + ty * 16 + i, k = k0 + tx;
        Wt[(size_t)n * 1024 + k] = f2bf(tl[tx * 65 + ty * 16 + i]);
      }
      __syncthreads();
    } else {
      const int t = it - 384 - 2112, g = t >> 2, d0 = (t & 3) * 8;
      float* sm = (float*)lds;
      float* Cr = sm; float* Ci = sm + 1024; float* Bbr = sm + 2048; float* Bbi = sm + 3072;
      float* Apr = sm + 4096; float* Api = sm + 4672; float* Wr = sm + 5248; float* Wi = sm + 6272;
      const float step = expf(p.s5_log_step[g]);
#pragma unroll
      for (int q = 0; q < 4; ++q) { const int idx = tid + q * 256; Cr[idx] = p.s5_c_re[g * 1024 + idx]; Ci[idx] = p.s5_c_im[g * 1024 + idx]; }
      if (tid < 64) {
        const int pp = tid;
        const float lr = p.s5_lam_re[g * 64 + pp], li = p.s5_lam_im[g * 64 + pp];
        const float mag = expf(lr * step);
        float sn, cn; sincosf(li * step, &sn, &cn);
        const float ar = mag * cn, ai = mag * sn;
        const float den = lr * lr + li * li, xr = ar - 1.0f;
        const float nr = (xr * lr + ai * li) / den, ni = (ai * lr - xr * li) / den;
#pragma unroll
        for (int c = 0; c < 16; ++c) {
          const float br = p.s5_b_re[(g * 64 + pp) * 16 + c], bi = p.s5_b_im[(g * 64 + pp) * 16 + c];
          Bbr[pp * 16 + c] = nr * br - ni * bi; Bbi[pp * 16 + c] = nr * bi + ni * br;
        }
        if (d0 == 0) {
          float* abar = (float*)(p.ws + W_ABAR);
          abar[(g * 64 + pp) * 2] = ar; abar[(g * 64 + pp) * 2 + 1] = ai;
          float* bb = (float*)(p.ws + W_BBAR);
#pragma unroll
          for (int c = 0; c < 16; ++c) {
            const float br = p.s5_b_re[(g * 64 + pp) * 16 + c], bi = p.s5_b_im[(g * 64 + pp) * 16 + c];
            bb[((g * 64 + pp) * 16 + c) * 2] = nr * br - ni * bi;
            bb[((g * 64 + pp) * 16 + c) * 2 + 1] = nr * bi + ni * br;
          }
        }
      }
#pragma unroll
      for (int q = 0; q < 3; ++q) {
        const int idx = tid + q * 256;
        if (idx < 576) {
          const int dd = idx >> 6, pp = idx & 63;
          const float lr = p.s5_lam_re[g * 64 + pp], li = p.s5_lam_im[g * 64 + pp];
          const float fd = (float)(d0 + dd);
          float s0, c0; sincosf(li * step * fd, &s0, &c0);
          const float m0 = expf(lr * step * fd);
          Apr[idx] = m0 * c0; Api[idx] = m0 * s0;
          if (d0 + dd == 32) { float* a64 = (float*)(p.ws + W_A64); a64[(g * 64 + pp) * 2] = m0 * c0; a64[(g * 64 + pp) * 2 + 1] = m0 * s0; }
        }
      }
      __syncthreads();
      bf16_t* ME = (bf16_t*)(p.ws + W_ME);
      bf16_t* MC = (bf16_t*)(p.ws + W_MC);
      bf16_t* KTb = (bf16_t*)(p.ws + W_KTAB);
      for (int dd = 0; dd < 8; ++dd) {
        const int d = d0 + dd;
#pragma unroll
        for (int q = 0; q < 4; ++q) {
          const int idx = tid + q * 256, pp = idx >> 4, c = idx & 15;
          const float ar = Apr[dd * 64 + pp], ai = Api[dd * 64 + pp], br = Bbr[idx], bi = Bbi[idx];
          const float wr_ = ar * br - ai * bi, wi_ = ar * bi + ai * br;
          Wr[idx] = wr_; Wi[idx] = wi_;
          ME[((size_t)(g * 128 + pp)) * 512 + (31 - d) * 16 + c] = f2bf(wr_);
          ME[((size_t)(g * 128 + 64 + pp)) * 512 + (31 - d) * 16 + c] = f2bf(wi_);
        }
        __syncthreads();
        {
          const int co = tid >> 4, ci = tid & 15;
          float s0 = 0.f, s1 = 0.f;
#pragma unroll 8
          for (int pp = 0; pp < 64; pp += 2) {
            s0 += Cr[co * 64 + pp] * Wr[pp * 16 + ci] - Ci[co * 64 + pp] * Wi[pp * 16 + ci];
            s1 += Cr[co * 64 + pp + 1] * Wr[(pp + 1) * 16 + ci] - Ci[co * 64 + pp + 1] * Wi[(pp + 1) * 16 + ci];
          }
          KTb[((size_t)(g * 16 + co) * 32 + d) * 16 + ci] = f2bf(s0 + s1);
        }
#pragma unroll
        for (int q = 0; q < 8; ++q) {
          const int idx = tid + q * 256, co = idx >> 7, k = idx & 127, pp = k & 63;
          const float cr = Cr[co * 64 + pp], cim = Ci[co * 64 + pp];
          const float a1r = Apr[(dd + 1) * 64 + pp], a1i = Api[(dd + 1) * 64 + pp];
          const float v = (k < 64) ? (cr * a1r - cim * a1i) : -(cr * a1i + cim * a1r);
          MC[((size_t)(g * 512 + d * 16 + co)) * 128 + k] = f2bf(v);
        }
        __syncthreads();
      }
    }
  }
}

DI void phase_norm_mod(const Params& p, const Sub& s, int layer, bool from_out, bf16_t* dst) {
  const int lane = VTID & 63, wave = VTID >> 6;
  const float* mod = (const float*)(p.ws + W_MOD);
  const float* gv = p.norm_g + layer * D;
  const int stride = s.vg * 4, rhi = s.samp ? M : MP;
  for (int r = (s.samp ? MP : 0) + s.vb * 4 + wave; r < rhi; r += 2 * stride) {
    const int rr[2] = {r, (r + stride < rhi) ? r + stride : r};
    const bool two = r + stride < rhi;
    float4 v[2][4], g4[4], sh[2][4], sc[2][4];
#pragma unroll
    for (int q = 0; q < 2; ++q) {
      if (from_out) {
        const bf16_t* srcb = (const bf16_t*)p.out + (size_t)rr[q] * D;
#pragma unroll
        for (int i = 0; i < 4; ++i) ld_bf4(srcb + i * 256 + lane * 4, v[q][i].x, v[q][i].y, v[q][i].z, v[q][i].w);
      } else {
        const float* src = xrow(p, rr[q]);
#pragma unroll
        for (int i = 0; i < 4; ++i) v[q][i] = *(const float4*)(src + i * 256 + lane * 4);
      }
      const float* mrow = mod + (size_t)(row_bi(rr[q]) * 2 + layer) * 3072;
#pragma unroll
      for (int i = 0; i < 4; ++i) { const int c = i * 256 + lane * 4; sh[q][i] = *(const float4*)(mrow + c); sc[q][i] = *(const float4*)(mrow + 1024 + c); }
    }
#pragma unroll
    for (int i = 0; i < 4; ++i) g4[i] = *(const float4*)(gv + i * 256 + lane * 4);
#pragma unroll
    for (int q = 0; q < 2; ++q) {
      float ss = 0.f;
#pragma unroll
      for (int i = 0; i < 4; ++i) ss += v[q][i].x * v[q][i].x + v[q][i].y * v[q][i].y + v[q][i].z * v[q][i].z + v[q][i].w * v[q][i].w;
      ss = wave_sum(ss);
      const float rs = rsqrtf(ss * (1.0f / D) + EPS);
      if (q == 0 || two) {
#pragma unroll
        for (int i = 0; i < 4; ++i) {
          const int c = i * 256 + lane * 4;
          st_bf4(dst + (size_t)rr[q] * D + c, v[q][i].x * rs * g4[i].x * (1.f + sc[q][i].x) + sh[q][i].x, v[q][i].y * rs * g4[i].y * (1.f + sc[q][i].y) + sh[q][i].y,
                 v[q][i].z * rs * g4[i].z * (1.f + sc[q][i].z) + sh[q][i].z, v[q][i].w * rs * g4[i].w * (1.f + sc[q][i].w) + sh[q][i].w);
        }
      }
    }
  }
}

DI void phase_g1(const Params& p, const Sub& s, char* lds_all) {
  const bf16_t* A = (const bf16_t*)(p.ws + W_SLOT0);
  const bf16_t* Bt = (const bf16_t*)(p.ws + W_S5IN);
  bf16_t* ugm = (bf16_t*)(p.ws + W_SLOT1);
  bf16_t* z = (bf16_t*)(p.ws + W_SLOT2);
  float* us = (float*)(p.ws + W_USAMP);
  {
    gemm_dispatch(s, lds_all, A, Bt, 8,
      [&](int, int) { return NoLoad{}; },
      [&](int row, int col, f32x4 v, const NoLoad&) {
        if (col < 1024) {
          if (row < MP) st_bf4(ugm + ((size_t)(col >> 4) * MP + row) * 16 + (col & 15), v[0], v[1], v[2], v[3]);
          else *(f32x4*)(us + (size_t)(row - MP) * D + col) = v;
        } else st_bf4(z + (size_t)row * D + (col - 1024), v[0], v[1], v[2], v[3]);
      });
  }
}

DI void phase_s5_e(const Params& p, char* lds) {
  const bf16_t* ugm = (const bf16_t*)(p.ws + W_SLOT1);
  const bf16_t* ME = (const bf16_t*)(p.ws + W_ME);
  float* E = (float*)(p.ws + W_E);
  const int nt = 64 * 16;
  for (int k_ = 0; k_ * VGRID < (nt); ++k_) {
    int L = k_ * VGRID + VBID; const bool active_ = L < (nt); if (!active_) L = (nt) - 1;
    const int g = L >> 4, mt = L & 15;
    const bf16_t* Ag = ugm + (size_t)g * MP * 16 + (size_t)mt * 128 * 512;
    gemm_tile(lds, 8, mt & 7,
      [&](int r, int kc) { return Ag + (size_t)r * 512 + kc * 8; },
      [&](int n, int kc) { return ME + (size_t)(g * 128 + n) * 512 + kc * 8; },
      [&](int r, int c, f32x4 v) { *(f32x4*)(E + ((size_t)g * 2048 + mt * 128 + r) * 128 + c) = v; });
  }
}

DI void phase_s5_sample(const Params& p, const Sub& s) {
  const int lane = VTID & 63, wave = VTID >> 6;
  const float* us = (const float*)(p.ws + W_USAMP);
  const float* abar = (const float*)(p.ws + W_ABAR);
  const float* bb = (const float*)(p.ws + W_BBAR);
  bf16_t* yg = (bf16_t*)(p.ws + W_SLOT3);
  for (int it = s.vb * 4 + wave; it < 1024; it += s.vg * 4) {
    const int b = it >> 6, g = it & 63;
    float xr = p.st_s5_re[(b * 64 + g) * 64 + lane], xi = p.st_s5_im[(b * 64 + g) * 64 + lane];
    const float ar = abar[(g * 64 + lane) * 2], ai = abar[(g * 64 + lane) * 2 + 1];
    float bbr[16], bbi[16], cr[16], ci[16];
#pragma unroll
    for (int c = 0; c < 16; ++c) {
      bbr[c] = bb[((g * 64 + lane) * 16 + c) * 2]; bbi[c] = bb[((g * 64 + lane) * 16 + c) * 2 + 1];
      cr[c] = p.s5_c_re[(g * 16 + c) * 64 + lane]; ci[c] = p.s5_c_im[(g * 16 + c) * 64 + lane];
    }
    const float dch = p.s5_d[g * 16 + (lane & 15)];
    for (int t = 0; t < 16; ++t) {
      const float* up = us + (size_t)(b * 16 + t) * D + g * 16;
      float br = 0.f, bi = 0.f;
#pragma unroll
      for (int c = 0; c < 16; ++c) { const float u = up[c]; br += bbr[c] * u; bi += bbi[c] * u; }
      const float nxr = ar * xr - ai * xi + br, nxi = ar * xi + ai * xr + bi;
      xr = nxr; xi = nxi;
      float yv = 0.f;
#pragma unroll
      for (int c = 0; c < 16; ++c) { const float s = wave_sum(cr[c] * xr - ci[c] * xi); if (lane == c) yv = s; }
      if (lane < 16) {
        const float u = up[lane];
        yg[(size_t)(MP + b * 16 + t) * D + g * 16 + lane] = f2bf(geluf_(yv + dch * u));
      }
    }
    p.out[O_S5RE_S + (b * 64 + g) * 64 + lane] = xr;
    p.out[O_S5IM_S + (b * 64 + g) * 64 + lane] = xi;
  }
}

DI void phase_s5_scan(const Params& p) {
  const float* E = (const float*)(p.ws + W_E);
  const float* a64 = (const float*)(p.ws + W_A64);
  bf16_t* H = (bf16_t*)(p.ws + W_H);
  for (int idx = VBID * 256 + VTID; idx < 8 * 64 * 64; idx += VGRID * 256) {
    const int pp = idx & 63, g = (idx >> 6) & 63, b = idx >> 12;
    const float ar = a64[(g * 64 + pp) * 2], ai = a64[(g * 64 + pp) * 2 + 1];
    float hr = 0.f, hi = 0.f;
    const size_t base = ((size_t)g * 2048 + b * 256) * 128;
    for (int n0 = 0; n0 < 256; n0 += 8) {
      float er[8], ei[8];
#pragma unroll
      for (int k = 0; k < 8; ++k) { er[k] = E[base + (size_t)(n0 + k) * 128 + pp]; ei[k] = E[base + (size_t)(n0 + k) * 128 + 64 + pp]; }
#pragma unroll
      for (int k = 0; k < 8; ++k) {
        H[base + (size_t)(n0 + k) * 128 + pp] = f2bf(hr); H[base + (size_t)(n0 + k) * 128 + 64 + pp] = f2bf(hi);
        const float nr = ar * hr - ai * hi + er[k], ni = ar * hi + ai * hr + ei[k];
        hr = nr; hi = ni;
      }
    }
    p.out[O_S5RE_P + (b * 64 + g) * 64 + pp] = hr;
    p.out[O_S5IM_P + (b * 64 + g) * 64 + pp] = hi;
  }
}

DI void phase_s5_y(const Params& p, char* lds) {
  const bf16_t* ugm = (const bf16_t*)(p.ws + W_SLOT1);
  const bf16_t* H = (const bf16_t*)(p.ws + W_H);
  const bf16_t* MC = (const bf16_t*)(p.ws + W_MC);
  const bf16_t* KT = (const bf16_t*)(p.ws + W_KTAB);
  bf16_t* yg = (bf16_t*)(p.ws + W_SLOT3);
  const bf16_t* zblk = (const bf16_t*)(p.ws + W_ZERO);
  const int nt = 64 * 8 * 8;
  for (int k_ = 0; k_ * VGRID < (nt); ++k_) {
    int L = k_ * VGRID + VBID; const bool active_ = L < (nt); if (!active_) L = (nt) - 1;
    const int j = 3 - (L >> 10), rem = L & 1023, g = rem >> 4, mt = rem & 15;
    const bf16_t* Ug = ugm + (size_t)g * MP * 16 + (size_t)mt * 128 * 512;
    const bf16_t* Hg = H + ((size_t)g * 2048 + mt * 128) * 128;
    gemm_tile(lds, 2 + 2 * (j + 1), 0,
      [&](int r, int kc) { return kc < 16 ? Hg + (size_t)r * 128 + kc * 8 : Ug + (size_t)r * 512 + (kc - 16) * 8; },
      [&](int n, int kc) {
        const int nn = j * 128 + n;
        if (kc < 16) return MC + ((size_t)g * 512 + nn) * 128 + kc * 8;
        const int t = nn >> 4, co = nn & 15, kk = (kc - 16) * 8, s = kk >> 4, ci0 = kk & 15;
        if (s > t) return zblk;
        return KT + ((size_t)(g * 16 + co) * 32 + (t - s)) * 16 + ci0;
      },
      [&](int r, int c) {
        const int nn = j * 128 + c, t = nn >> 4, co = nn & 15, cr = mt * 128 + r;
        const size_t tok = (size_t)cr * 32 + t;
        LdY l; l.u = *(const uint2*)(ugm + ((size_t)g * MP + tok) * 16 + co); l.d = *(const float4*)(p.s5_d + g * 16 + co);
        return l;
      },
      [&](int r, int c, f32x4 v, const LdY& ly) {
        const uint2 uu = ly.u;
        const int nn = j * 128 + c, t = nn >> 4, co = nn & 15, cr = mt * 128 + r;
        const size_t tok = (size_t)cr * 32 + t;
        const float u0 = __uint_as_float(uu.x << 16), u1 = __uint_as_float(uu.x & 0xffff0000u), u2 = __uint_as_float(uu.y << 16), u3 = __uint_as_float(uu.y & 0xffff0000u);
        const float4 d4 = ly.d;
        st_bf4(yg + tok * D + g * 16 + co, geluf_(v[0] + d4.x * u0), geluf_(v[1] + d4.y * u1), geluf_(v[2] + d4.z * u2), geluf_(v[3] + d4.w * u3));
      });
  }
}

DI void phase_g2(const Params& p, const Sub& s, char* lds_all) {
  const bf16_t* A = (const bf16_t*)(p.ws + W_SLOT3);
  const bf16_t* Bt = (const bf16_t*)(p.ws + W_GLU);
  const bf16_t* z = (const bf16_t*)(p.ws + W_SLOT2);
  bf16_t* y2 = (bf16_t*)(p.ws + W_SLOT0);
  {
    gemm_dispatch(s, lds_all, A, Bt, 4,
      [&](int row, int col) { const size_t o = (size_t)row * D + col; Ld2 r; const uint2 a = *(const uint2*)(A + o), b = *(const uint2*)(z + o);
        r.a.x = __uint_as_float(a.x); r.a.y = __uint_as_float(a.y); r.a.z = __uint_as_float(b.x); r.a.w = __uint_as_float(b.y); r.b = *(const float4*)(p.s5_b_glu + col); return r; },
      [&](int row, int col, f32x4 v, const Ld2& l2) {
        uint4 ld; ld.x = __float_as_uint(l2.a.x); ld.y = __float_as_uint(l2.a.y); ld.z = __float_as_uint(l2.a.z); ld.w = __float_as_uint(l2.a.w);
        const size_t o = (size_t)row * D + col;
        const float y0 = __uint_as_float(ld.x << 16), y1 = __uint_as_float(ld.x & 0xffff0000u), y2_ = __uint_as_float(ld.y << 16), y3 = __uint_as_float(ld.y & 0xffff0000u);
        const float z0 = __uint_as_float(ld.z << 16), z1 = __uint_as_float(ld.z & 0xffff0000u), z2 = __uint_as_float(ld.w << 16), z3 = __uint_as_float(ld.w & 0xffff0000u);
        const float4 b4 = l2.b;
        st_bf4(y2 + o, y0 * sigmoidf_(v[0] + b4.x) * siluf_(z0), y1 * sigmoidf_(v[1] + b4.y) * siluf_(z1),
               y2_ * sigmoidf_(v[2] + b4.z) * siluf_(z2), y3 * sigmoidf_(v[3] + b4.w) * siluf_(z3));
      });
  }
}

DI void phase_gout(const Params& p, const Sub& s, char* lds_all, int layer, const bf16_t* A, const bf16_t* Bt) {
  const float* mod = (const float*)(p.ws + W_MOD);
  {
    gemm_dispatch(s, lds_all, A, Bt, 4,
      [&](int row, int col) {
        const bf16_t* x1b = (const bf16_t*)p.out;
        float4 x4;
        if (layer == 0) x4 = *(const float4*)(xrow(p, row) + col);
        else ld_bf4(x1b + (size_t)row * D + col, x4.x, x4.y, x4.z, x4.w);
        Ld2 r; r.a = x4; r.b = *(const float4*)(mod + (size_t)(row_bi(row) * 2 + layer) * 3072 + 2048 + col);
        return r;
      },
      [&](int row, int col, f32x4 v, const Ld2& l2) {
        const float4 x4 = l2.a, g4 = l2.b;
        bf16_t* x1b = (bf16_t*)p.out;
        bf16_t* x2b = (bf16_t*)(p.ws + W_SLOT3);
        st_bf4((layer == 0 ? x1b : x2b) + (size_t)row * D + col, x4.x + g4.x * v[0], x4.y + g4.y * v[1], x4.z + g4.z * v[2], x4.w + g4.w * v[3]);
      });
  }
}

DI void phase_g4(const Params& p, const Sub& s, char* lds_all) {
  const bf16_t* A = (const bf16_t*)(p.ws + W_SLOT0);
  const bf16_t* Bt = (const bf16_t*)(p.ws + W_GDNIN);
  bf16_t* qkv = (bf16_t*)(p.ws + W_SLOT2);
  bf16_t* z1 = (bf16_t*)(p.ws + W_SLOT1);
  float* ba = (float*)(p.ws + W_BA);
  {
    gemm_dispatch(s, lds_all, A, Bt, s.samp ? 13 : 12,
      [&](int, int) { return NoLoad{}; },
      [&](int row, int col, f32x4 v, const NoLoad&) {
        if (col < 2048) {
          st_bf4(qkv + (size_t)row * 2048 + col, v[0], v[1], v[2], v[3]);
          if (row < MP) { const int l = row & 8191; if (l >= 8189) *(f32x4*)(p.out + O_CONV_P + ((size_t)(row >> 13) * 3 + (l - 8189)) * 2048 + col) = v; }
          else { const int l = (row - MP) & 15; if (l >= 13) *(f32x4*)(p.out + O_CONV_S + ((size_t)((row - MP) >> 4) * 3 + (l - 13)) * 2048 + col) = v; }
        } else if (col < 3072) st_bf4(z1 + (size_t)row * D + (col - 2048), v[0], v[1], v[2], v[3]);
        else if (col < 3088) *(f32x4*)(ba + (size_t)row * 16 + (col - 3072)) = v;
      });
  }
  if (!s.samp) {
    const int tidx = otid(), wid = tidx >> 6, lane = tidx & 63, fr = lane & 15, fq = lane >> 4;
    for (int rt = blockIdx.x; rt < 256; rt += gridDim.x) {
      const int r0 = rt * 256 + wid * 32;
      const bf16_t* a0p = A + (size_t)(r0 + fr) * D + fq * 8;
      const bf16_t* a1p = a0p + (size_t)16 * D;
      const bf16_t* bp = Bt + (size_t)(3072 + fr) * D + fq * 8;
      f32x4 c0 = (f32x4){0.f, 0.f, 0.f, 0.f}, c1 = (f32x4){0.f, 0.f, 0.f, 0.f};
#pragma unroll 8
      for (int ks = 0; ks < 32; ++ks) {
        const bf16x8 bb = *(const bf16x8*)(bp + ks * 32);
        const bf16x8 x0 = *(const bf16x8*)(a0p + ks * 32), x1 = *(const bf16x8*)(a1p + ks * 32);
        c0 = MFMA16(bb, x0, c0); c1 = MFMA16(bb, x1, c1);
      }
      *(f32x4*)(ba + (size_t)(r0 + fr) * 16 + 4 * fq) = c0;
      *(f32x4*)(ba + (size_t)(r0 + 16 + fr) * 16 + 4 * fq) = c1;
    }
  }
}

DI void phase_gdn_prep(const Params& p, const Sub& s, char* lds) {
  const bf16_t* qkv = (const bf16_t*)(p.ws + W_SLOT2);
  const float* ba = (const float*)(p.ws + W_BA);
  bf16_t* GW = (bf16_t*)(p.ws + W_GW); bf16_t* GU = (bf16_t*)(p.ws + W_GU); bf16_t* GQK = (bf16_t*)(p.ws + W_GQK);
  bf16_t* GQ = (bf16_t*)(p.ws + W_GQ); bf16_t* GKT = (bf16_t*)(p.ws + W_GKT); float* GGC = (float*)(p.ws + W_GGC);
  char* R0 = lds; char* R1 = lds + 16384; char* R2 = lds + 32768; char* R3 = lds + 49152;
  const int it_lo = s.samp ? 4096 : 0, it_n = s.samp ? 64 : 4096;
  for (int k_ = 0; k_ * s.vg < it_n; ++k_) {
    int it = k_ * s.vg + s.vb;
    if (k_ * s.vg + (s.vb & ~1) >= it_n) continue;
    if (it >= it_n) it = it_n - 1;
    it += it_lo;
    const int cid = it >> 2, hq = it & 3;
    f32x4 akk[4], aqk[4];
#pragma unroll
    for (int hvi = 0; hvi < 2; ++hvi) {
    const int hv = 2 * hq + hvi;
    const int tid = VTID, lane = tid & 63, wave = tid >> 6, fr = lane & 15, fq = lane >> 4;
    const bool samp = cid >= 1024;
    const int row0 = samp ? MP + (cid - 1024) * 16 : cid * 64;
    const int tv = samp ? 16 : 64;
    const bool first = samp ? false : ((cid & 127) == 0);
    const int sb = cid - 1024;
    float beta = 0.f, gg = 0.f;
    if (lane < tv) {
      const float braw = ba[(size_t)(row0 + lane) * 16 + hv], araw = ba[(size_t)(row0 + lane) * 16 + 8 + hv];
      beta = sigmoidf_(braw);
      const float xx = araw + p.gdn_dt_bias[hv];
      const float sp = xx > 20.f ? xx : log1pf(expf(xx));
      gg = -expf(p.gdn_a_log[hv]) * sp;
    }
    float gcum = gg;
#pragma unroll
    for (int o = 1; o < 64; o <<= 1) { const float t = __shfl_up(gcum, o); if (lane >= o) gcum += t; }
    if (wave == 0) {
      const float gl_ = __shfl(gcum, 63);
      float* ge = GGC + ((size_t)cid * 8 + hv) * 256;
      ge[lane] = __expf(gcum); ge[64 + lane] = __expf(gl_ - gcum);
      if (lane == 0) ge[128] = __expf(gl_);
    }
    const int ln = lane;
    const bool hist_ok = !samp && !first;
#pragma unroll
    for (int seg = 0; seg < 3; ++seg) {
      if (seg < 2 && hvi == 1) continue;
      const int cb = seg == 0 ? hq * 128 : (seg == 1 ? 512 + hq * 128 : 1024 + hv * 128);
      const int ch = cb + 2 * ln;
      const float2 w0 = *(const float2*)(p.gdn_conv_w + 0 * 2048 + ch), w1 = *(const float2*)(p.gdn_conv_w + 1 * 2048 + ch);
      const float2 w2 = *(const float2*)(p.gdn_conv_w + 2 * 2048 + ch), w3 = *(const float2*)(p.gdn_conv_w + 3 * 2048 + ch);
      const int t0 = wave * 16, d0 = 2 * ln;
      float2 xs[19];
      {
        unsigned xu[19];
#pragma unroll
        for (int j = 0; j < 19; ++j) {
          const int trel = t0 - 3 + j;
          const bool ok = (trel < tv) && (trel >= 0 || hist_ok);
          xu[j] = *(const unsigned*)(qkv + (size_t)(ok ? row0 + trel : row0) * 2048 + ch);
        }
#pragma unroll
        for (int j = 0; j < 19; ++j) {
          const int trel = t0 - 3 + j;
          const bool ok = (trel < tv) && (trel >= 0 || hist_ok);
          xs[j].x = ok ? __uint_as_float(xu[j] << 16) : 0.f; xs[j].y = ok ? __uint_as_float(xu[j] & 0xffff0000u) : 0.f;
        }
        if (samp && wave == 0) {
#pragma unroll
          for (int j = 0; j < 3; ++j) xs[j] = *(const float2*)(p.st_conv + ((size_t)sb * 3 + j) * 2048 + ch);
        }
      }
      unsigned tp0[8], tp1[8];
      float a0v[16], a1v[16], ssv[16];
#pragma unroll
      for (int tt = 0; tt < 16; ++tt) {
        a0v[tt] = siluf_(w0.x * xs[tt].x + w1.x * xs[tt + 1].x + w2.x * xs[tt + 2].x + w3.x * xs[tt + 3].x);
        a1v[tt] = siluf_(w0.y * xs[tt].y + w1.y * xs[tt + 1].y + w2.y * xs[tt + 2].y + w3.y * xs[tt + 3].y);
        ssv[tt] = a0v[tt] * a0v[tt] + a1v[tt] * a1v[tt];
      }
      if (seg < 2) {
#pragma unroll
        for (int tt = 0; tt < 16; ++tt) ssv[tt] = row16_sum(ssv[tt]);
#pragma unroll
        for (int o = 16; o <= 32; o <<= 1) {
#pragma unroll
          for (int tt = 0; tt < 16; ++tt) ssv[tt] += __shfl_xor(ssv[tt], o);
        }
      }
#pragma unroll
      for (int tt = 0; tt < 16; ++tt) {
        const int t = t0 + tt;
        float a0 = a0v[tt], a1 = a1v[tt];
        if (seg < 2) {
          float rs = rsqrtf(ssv[tt] + EPS);
          if (seg == 0) rs *= 0.08838834764831845f;
          a0 *= rs; a1 *= rs;
        }
        if (t >= tv) { a0 = 0.f; a1 = 0.f; }
        if (seg == 0) {
          *(unsigned*)(R2 + t * 256 + (((d0 >> 3) ^ (t & 7)) << 4) + (d0 & 7) * 2) = pack2(a0, a1);
          *(unsigned*)(GQ + (((size_t)cid * 4 + hq) * 64 + t) * 128 + kperm(d0)) = pack2(a0, a1);
        } else {
          if (seg == 1) *(unsigned*)(R0 + t * 256 + (((d0 >> 3) ^ (t & 7)) << 4) + (d0 & 7) * 2) = pack2(a0, a1);
          a0v[tt] = a0; a1v[tt] = a1;
        }
      }
      if (seg >= 1) {
#pragma unroll
        for (int q = 0; q < 8; ++q) { tp0[q] = pack2(a0v[2 * q], a0v[2 * q + 1]); tp1[q] = pack2(a1v[2 * q], a1v[2 * q + 1]); }
      }
      if (seg >= 1) {
        char* dst = seg == 1 ? R1 : R3;
#pragma unroll
        for (int h = 0; h < 2; ++h) {
          const int chk = 2 * wave + h;
          uint4 v0, v1;
          v0.x = tp0[4 * h]; v0.y = tp0[4 * h + 1]; v0.z = tp0[4 * h + 2]; v0.w = tp0[4 * h + 3];
          v1.x = tp1[4 * h]; v1.y = tp1[4 * h + 1]; v1.z = tp1[4 * h + 2]; v1.w = tp1[4 * h + 3];
          *(uint4*)(dst + d0 * 128 + ((chk ^ (d0 & 7)) << 4)) = v0;
          *(uint4*)(dst + (d0 + 1) * 128 + ((chk ^ ((d0 + 1) & 7)) << 4)) = v1;
        }
      }
    }
    lds_barrier();
    if (hvi == 0) {
#pragma unroll
    for (int n = 0; n < 4; ++n) { akk[n] = (f32x4){0.f, 0.f, 0.f, 0.f}; aqk[n] = (f32x4){0.f, 0.f, 0.f, 0.f}; }
#pragma unroll
    for (int ks = 0; ks < 4; ++ks) {
      const bf16x8 ak = ldfrag(R0, 256, wave * 16 + fr, ks * 4 + fq), aq = ldfrag(R2, 256, wave * 16 + fr, ks * 4 + fq);
#pragma unroll
      for (int n = 0; n < 4; ++n) {
        const bf16x8 bk = ldfrag(R0, 256, n * 16 + fr, ks * 4 + fq);
        akk[n] = MFMA16(ak, bk, akk[n]); aqk[n] = MFMA16(aq, bk, aqk[n]);
      }
    }
    }
    lds_barrier();
    {
      float* Mx = (float*)R0;
#pragma unroll
      for (int n = 0; n < 4; ++n) {
        const int jj = n * 16 + fr;
        const float gj = __shfl(gcum, jj);
#pragma unroll
        for (int j = 0; j < 4; ++j) {
          const int i = wave * 16 + 4 * fq + j;
          const float gi = __shfl(gcum, i), bi = __shfl(beta, i);
          const float dec = (i >= jj) ? __expf(gi - gj) : 0.f;
          Mx[i * 64 + jj] = (i > jj) ? bi * akk[n][j] * dec : 0.f;
          GQK[(((size_t)cid * 8 + hv) * 64 + i) * 64 + kperm(jj)] = f2bf(aqk[n][j] * dec);
        }
      }
    }
    lds_barrier();
    if ((hv & 1) == 0) {
#pragma unroll
      for (int q = 0; q < 4; ++q) {
        const int Lc = tid + q * 256, row = Lc >> 3, ch = Lc & 7;
        { const uint4 v_ = *(const uint4*)(R1 + row * 128 + ((ch ^ (row & 7)) << 4)); bf16_t* d_ = GKT + (((size_t)cid * 4 + hq) * 128 + row) * 64;
          uint2 lo_, hi_; lo_.x = v_.x; lo_.y = v_.y; hi_.x = v_.z; hi_.y = v_.w;
          *(uint2*)(d_ + kperm(ch * 8)) = lo_; *(uint2*)(d_ + kperm(ch * 8 + 4)) = hi_; }
      }
    }
    {
      const float* Mx = (const float*)R0;
      bf16_t* XT = (bf16_t*)R2;
      bf16_t* Xr = (bf16_t*)(R2 + 8192);
      {
        const int a = wave, c = lane & 15;
        float x[16];
#pragma unroll
        for (int i = 0; i < 16; ++i) {
          const float mrow = Mx[(16 * a + i) * 64 + 16 * a + c];
          float s0 = (c == i) ? 1.f : 0.f, s1 = 0.f;
#pragma unroll
          for (int j = 0; j < i; ++j) {
            const float mv = __int_as_float(__builtin_amdgcn_readlane(__float_as_int(mrow), j));
            if (j & 1) s1 -= mv * x[j]; else s0 -= mv * x[j];
          }
          x[i] = s0 + s1;
        }
        if (lane < 16) {
#pragma unroll
          for (int i = 0; i < 16; ++i) Xr[(16 * a + i) * 64 + 16 * a + c] = f2bf(x[i]);
          uint4 v0, v1;
          v0.x = pack2(x[0], x[1]); v0.y = pack2(x[2], x[3]); v0.z = pack2(x[4], x[5]); v0.w = pack2(x[6], x[7]);
          v1.x = pack2(x[8], x[9]); v1.y = pack2(x[10], x[11]); v1.z = pack2(x[12], x[13]); v1.w = pack2(x[14], x[15]);
          *(uint4*)(XT + (16 * a + c) * 64 + 16 * a) = v0;
          *(uint4*)(XT + (16 * a + c) * 64 + 16 * a + 8) = v1;
        }
      }
      lds_barrier();
      typedef unsigned u32x4 __attribute__((ext_vector_type(4)));
#pragma unroll
      for (int a = 1; a < 4; ++a) {
        if (wave < a) {
          const int b = wave, len = 16 * (a - b);
          f32x4 T = (f32x4){0.f, 0.f, 0.f, 0.f};
#pragma unroll
          for (int kk = 0; kk < 2; ++kk) {
            if (kk * 32 < len) {
              const int k0 = kk * 32 + fq * 8;
              u32x4 av = (u32x4){0u, 0u, 0u, 0u}, bv = (u32x4){0u, 0u, 0u, 0u};
              if (k0 < len) {
                const float* mp = Mx + (16 * a + fr) * 64 + 16 * b + k0;
                const float4 m0 = *(const float4*)mp, m1 = *(const float4*)(mp + 4);
                av[0] = pack2(m0.x, m0.y); av[1] = pack2(m0.z, m0.w); av[2] = pack2(m1.x, m1.y); av[3] = pack2(m1.z, m1.w);
                bv = *(const u32x4*)(XT + (16 * b + fr) * 64 + 16 * b + k0);
              }
              T = MFMA16(__builtin_bit_cast(bf16x8, av), __builtin_bit_cast(bf16x8, bv), T);
            }
          }
          const uint2 dv = *(const uint2*)(Xr + (16 * a + fr) * 64 + 16 * a + 4 * fq);
          u32x4 ad = (u32x4){dv.x, dv.y, 0u, 0u}, bt = (u32x4){pack2(T[0], T[1]), pack2(T[2], T[3]), 0u, 0u};
          const f32x4 Xab = MFMA16(__builtin_bit_cast(bf16x8, ad), __builtin_bit_cast(bf16x8, bt), ((f32x4){0.f, 0.f, 0.f, 0.f}));
          uint2 xo; xo.x = pack2(-Xab[0], -Xab[1]); xo.y = pack2(-Xab[2], -Xab[3]);
          *(uint2*)(XT + (16 * b + fr) * 64 + 16 * a + 4 * fq) = xo;
#pragma unroll
          for (int j = 0; j < 4; ++j) Xr[(16 * a + 4 * fq + j) * 64 + 16 * b + fr] = f2bf(-Xab[j]);
        }
        lds_barrier();
      }
      {
        const int i = tid >> 2, cg = tid & 3;
        const uint4 r0 = *(const uint4*)(Xr + i * 64 + cg * 16), r1 = *(const uint4*)(Xr + i * 64 + cg * 16 + 8);
        const unsigned rw[8] = {r0.x, r0.y, r0.z, r0.w, r1.x, r1.y, r1.z, r1.w};
        float aw[16], au[16];
#pragma unroll
        for (int q = 0; q < 16; ++q) {
          const int j = cg * 16 + q;
          const float bj = __shfl(beta, j), gj = __shfl(gcum, j);
          const float xraw = (q & 1) ? __uint_as_float(rw[q >> 1] & 0xffff0000u) : __uint_as_float(rw[q >> 1] << 16);
          const float xx = ((i >> 4) >= cg) ? xraw : 0.f;
          au[q] = xx * bj; aw[q] = xx * bj * __expf(gj);
        }
        lds_barrier();
#pragma unroll
        for (int h = 0; h < 2; ++h) {
          uint4 vw, vu;
          vw.x = pack2(aw[8 * h], aw[8 * h + 1]); vw.y = pack2(aw[8 * h + 2], aw[8 * h + 3]); vw.z = pack2(aw[8 * h + 4], aw[8 * h + 5]); vw.w = pack2(aw[8 * h + 6], aw[8 * h + 7]);
          vu.x = pack2(au[8 * h], au[8 * h + 1]); vu.y = pack2(au[8 * h + 2], au[8 * h + 3]); vu.z = pack2(au[8 * h + 4], au[8 * h + 5]); vu.w = pack2(au[8 * h + 6], au[8 * h + 7]);
          const int o = i * 128 + (((2 * cg + h) ^ (i & 7)) << 4);
          *(uint4*)(R2 + o) = vw; *(uint4*)(R2 + 8192 + o) = vu;
        }
      }
    }
    lds_barrier();
    {
      const bf16x8 aw0 = ldfrag(R2, 128, wave * 16 + fr, fq), aw1 = ldfrag(R2, 128, wave * 16 + fr, 4 + fq);
      const bf16x8 au0 = ldfrag(R2 + 8192, 128, wave * 16 + fr, fq), au1 = ldfrag(R2 + 8192, 128, wave * 16 + fr, 4 + fq);
      const size_t ob = (((size_t)cid * 8 + hv) * 64 + wave * 16 + fr) * 128;
#pragma unroll
      for (int n = 0; n < 8; ++n) {
        f32x4 cw = (f32x4){0.f, 0.f, 0.f, 0.f}, cu = (f32x4){0.f, 0.f, 0.f, 0.f};
        cw = MFMA16(ldfrag(R1, 128, n * 16 + fr, fq), aw0, cw); cw = MFMA16(ldfrag(R1, 128, n * 16 + fr, 4 + fq), aw1, cw);
        cu = MFMA16(au0, ldfrag(R3, 128, n * 16 + fr, fq), cu); cu = MFMA16(au1, ldfrag(R3, 128, n * 16 + fr, 4 + fq), cu);
        st_bf4(GW + ob + kperm(n * 16 + 4 * fq), cw[0], cw[1], cw[2], cw[3]);
        st_bf4(GU + ((size_t)cid * 8 + hv) * 8192 + ((n * 4 + wave) * 64 + lane) * 4, cu[0], cu[1], cu[2], cu[3]);
      }
    }
    lds_barrier();
    }
  }
}

DI void phase_gdn_seq(const Params& p, const Sub& s, char* lds_all) {
  const int tid = VTID, lane = tid & 63, wave = tid >> 6, fr = lane & 15, fq = lane >> 4;
  const bf16_t* GW = (const bf16_t*)(p.ws + W_GW); const bf16_t* GU = (const bf16_t*)(p.ws + W_GU); const bf16_t* GQK = (const bf16_t*)(p.ws + W_GQK);
  const bf16_t* GQ = (const bf16_t*)(p.ws + W_GQ); const bf16_t* GKT = (const bf16_t*)(p.ws + W_GKT); const float* GGC = (const float*)(p.ws + W_GGC);
  bf16_t* O = (bf16_t*)(p.ws + W_SLOT0);
  for (int rb = blockIdx.x; rb < 256; rb += gridDim.x) {
    if ((rb >= 128) != s.samp) continue;
    const int hh = otid() >> 8;
    const bool act = rb >= 128 || hh == 0;
    const int it = rb < 128 ? rb : 128 + (rb - 128) * 2 + hh;
    const bool samp = it >= 128;
    int b, hv, half, nsteps, cid0;
    if (!samp) { b = it >> 4; hv = (it >> 1) & 7; half = it & 1; nsteps = 128; cid0 = b * 128; }
    else { const int s = it - 128; b = s >> 4; hv = (s >> 1) & 7; half = s & 1; nsteps = 1; cid0 = 1024 + b; }
    const int hq = hv >> 1, dv0 = half * 64 + wave * 16;
    const int tv = samp ? 16 : 64;
    f32x4 S[8];
#pragma unroll
    for (int m = 0; m < 8; ++m) {
      S[m] = (f32x4){0.f, 0.f, 0.f, 0.f};
      if (samp && act) {
#pragma unroll
        for (int j = 0; j < 4; ++j) S[m][j] = p.st_gdn[(((size_t)b * 8 + hv) * 128 + m * 16 + 4 * fq + j) * 128 + dv0 + fr];
      }
    }
#define DMA_GT(cid_, slot_) do { if (wave == 0) __builtin_amdgcn_global_load_lds((const unsigned*)(GGC + ((size_t)(cid_) * 8 + hv) * 256 + lane * 4), \
      (LAS unsigned*)((LAS char*)lds_all + 131072 + (slot_) * 1024 + lane * 16), 16, 0, 0); } while (0)
    char* lbase = rb < 128 ? lds_all : lds_all + ((otid() >> 8) << 16);
    LAS char* l3 = (LAS char*)lbase;
#define DMA16(gp, loff) __builtin_amdgcn_global_load_lds((const unsigned*)(gp), (LAS unsigned*)(l3 + boff__ + (loff)), 16, 0, 0)
#define DMA_WU(cid_, bo_) do { const int cid__ = (cid_); const int boff__ = (bo_); \
      const bf16_t* sw = GW + ((size_t)cid__ * 8 + hv) * 8192; \
      const bf16_t* su = GU + ((size_t)cid__ * 8 + hv) * 8192 + half * 4096; \
      _Pragma("unroll") for (int i = 0; i < 4; ++i) { const int id = tid + i * 256, r = id >> 4, c = (id & 15) ^ (r & 7); DMA16(sw + r * 128 + c * 8, id * 16); } \
      _Pragma("unroll") for (int i = 0; i < 2; ++i) { const int id = tid + i * 256, r = id >> 3, c = id & 7; DMA16(su + id * 8, 57344 + id * 16); } } while (0)
#define DMA_QK(cid_, bo_) do { const int cid__ = (cid_); const int boff__ = (bo_); \
      const bf16_t* sq = GQ + ((size_t)cid__ * 4 + hq) * 8192; \
      const bf16_t* sk = GKT + ((size_t)cid__ * 4 + hq) * 8192; \
      const bf16_t* sqk = GQK + ((size_t)cid__ * 8 + hv) * 4096; \
      _Pragma("unroll") for (int i = 0; i < 4; ++i) { const int id = tid + i * 256, r = id >> 4, c = (id & 15) ^ (r & 7); DMA16(sq + r * 128 + c * 8, 16384 + id * 16); } \
      _Pragma("unroll") for (int i = 0; i < 4; ++i) { const int id = tid + i * 256, r = id >> 3, c = (id & 7) ^ (r & 7); DMA16(sk + r * 64 + c * 8, 32768 + id * 16); } \
      _Pragma("unroll") for (int i = 0; i < 2; ++i) { const int id = tid + i * 256, r = id >> 3, c = (id & 7) ^ (r & 7); DMA16(sqk + r * 64 + c * 8, 49152 + id * 16); } } while (0)
    const bool ldr = rb < 128 ? (hh == 1) : true;
    if (ldr) { DMA_WU(cid0, 0); DMA_QK(cid0, 0); DMA_GT(cid0, rb < 128 ? 0 : hh); }
    asm volatile("s_waitcnt vmcnt(0)" ::: "memory");
    __syncthreads();
    for (int n = 0; n < nsteps; ++n) {
      const int tid = VTID, lane = tid & 63, wave = tid >> 6, fr = lane & 15, fq = lane >> 4;
      const int dv0 = half * 64 + wave * 16;
      const int row0 = samp ? MP + b * 16 : (cid0 + n) * 64;
      const int bcur = (rb < 128) ? ((n & 1) << 16) : 0, bnxt = bcur ^ 65536;
      const char* Lw = lbase + bcur; const char* Lq = Lw + 16384; const char* Lk = Lw + 32768; const char* Lqk = Lw + 49152; const char* Lu = Lw + 57344;
      if (n + 1 < nsteps) {
        if (ldr) { DMA_WU(cid0 + n + 1, bnxt); DMA_QK(cid0 + n + 1, bnxt); DMA_GT(cid0 + n + 1, (n + 1) & 1); }
      }
      bf16x8 Sb[4];
#pragma unroll
      for (int c = 0; c < 4; ++c) Sb[c] = mkfrag(S[2 * c], S[2 * c + 1]);
      const float* Lt = (const float*)(lds_all + 131072 + ((rb < 128) ? (n & 1) : hh) * 1024);
      bf16x8 VN[2], VD[2];
      float eg[4][4];
#pragma unroll
      for (int c = 0; c < 2; ++c) { VN[c] = Sb[0]; VD[c] = Sb[0]; }
#pragma unroll
      for (int i = 0; i < 4; ++i)
#pragma unroll
        for (int j = 0; j < 4; ++j) eg[i][j] = 0.f;
      if (act) {
        f32x4 vn[4], vd[4], wsv[4];
        bf16x8 aw[4][4];
        float uu[4][4], gtv[4][4];
#pragma unroll
        for (int i = 0; i < 4; ++i)
#pragma unroll
          for (int c = 0; c < 4; ++c) aw[i][c] = ldfrag(Lw, 256, i * 16 + fr, 4 * c + fq);
#pragma unroll
        for (int i = 0; i < 4; ++i) {
          const uint2 u2 = *(const uint2*)(Lu + ((wave * 4 + i) * 64 + lane) * 8);
          uu[i][0] = __uint_as_float(u2.x << 16); uu[i][1] = __uint_as_float(u2.x & 0xffff0000u);
          uu[i][2] = __uint_as_float(u2.y << 16); uu[i][3] = __uint_as_float(u2.y & 0xffff0000u);
          { const float4 e4 = *(const float4*)(Lt + 64 + i * 16 + 4 * fq), g4 = *(const float4*)(Lt + i * 16 + 4 * fq);
            gtv[i][0] = e4.x; gtv[i][1] = e4.y; gtv[i][2] = e4.z; gtv[i][3] = e4.w;
            eg[i][0] = g4.x; eg[i][1] = g4.y; eg[i][2] = g4.z; eg[i][3] = g4.w; }
        }
#pragma unroll
        for (int i = 0; i < 4; ++i) wsv[i] = (f32x4){0.f, 0.f, 0.f, 0.f};
#pragma unroll
        for (int c = 0; c < 4; ++c)
#pragma unroll
          for (int i = 0; i < 4; ++i) wsv[i] = MFMA16(aw[i][c], Sb[c], wsv[i]);
#pragma unroll
        for (int i = 0; i < 4; ++i) {
          const f32x4 ws_ = wsv[i];
#pragma unroll
          for (int j = 0; j < 4; ++j) {
            const float u = uu[i][j];
            vn[i][j] = u - ws_[j];
            vd[i][j] = vn[i][j] * gtv[i][j];
          }
        }
#pragma unroll
        for (int c = 0; c < 2; ++c) { VN[c] = mkfrag(vn[2 * c], vn[2 * c + 1]); VD[c] = mkfrag(vd[2 * c], vd[2 * c + 1]); }
      }
      if (act) {
#pragma unroll
      for (int ih = 0; ih < 2; ++ih) {
        bf16x8 aq[2][4], aqk[2][2];
        f32x4 qsv[2];
#pragma unroll
        for (int ii = 0; ii < 2; ++ii) {
          const int i = ih * 2 + ii;
#pragma unroll
          for (int c = 0; c < 4; ++c) aq[ii][c] = ldfrag(Lq, 256, i * 16 + fr, 4 * c + fq);
#pragma unroll
          for (int c = 0; c < 2; ++c) aqk[ii][c] = ldfrag(Lqk, 128, i * 16 + fr, 4 * c + fq);
          qsv[ii] = (f32x4){0.f, 0.f, 0.f, 0.f};
        }
#pragma unroll
        for (int c = 0; c < 4; ++c)
#pragma unroll
          for (int ii = 0; ii < 2; ++ii) qsv[ii] = MFMA16(aq[ii][c], Sb[c], qsv[ii]);
#pragma unroll
        for (int ii = 0; ii < 2; ++ii)
#pragma unroll
          for (int j = 0; j < 4; ++j) qsv[ii][j] *= eg[ih * 2 + ii][j];
#pragma unroll
        for (int c = 0; c < 2; ++c)
#pragma unroll
          for (int ii = 0; ii < 2; ++ii) qsv[ii] = MFMA16(aqk[ii][c], VN[c], qsv[ii]);
#pragma unroll
        for (int ii = 0; ii < 2; ++ii)
#pragma unroll
          for (int j = 0; j < 4; ++j) {
            const int t = (ih * 2 + ii) * 16 + 4 * fq + j;
            if (t < tv) O[(size_t)(row0 + t) * D + hv * 128 + dv0 + fr] = f2bf(qsv[ii][j]);
          }
      }
      const float dec = Lt[128];
      {
        bf16x8 ak[8][2];
#pragma unroll
        for (int m = 0; m < 8; ++m) {
#pragma unroll
          for (int c = 0; c < 2; ++c) ak[m][c] = ldfrag(Lk, 128, m * 16 + fr, 4 * c + fq);
          S[m] = S[m] * dec;
        }
#pragma unroll
        for (int c = 0; c < 2; ++c)
#pragma unroll
          for (int m = 0; m < 8; ++m) S[m] = MFMA16(ak[m][c], VD[c], S[m]);
      }
      }
      asm volatile("s_waitcnt vmcnt(0)" ::: "memory");
      __syncthreads();
    }
    float* so = p.out + (samp ? O_GDN_S : O_GDN_P) + ((size_t)b * 8 + hv) * 16384;
    if (act) {
#pragma unroll
    for (int m = 0; m < 8; ++m)
#pragma unroll
      for (int j = 0; j < 4; ++j) so[(m * 16 + 4 * fq + j) * 128 + dv0 + fr] = S[m][j];
    }
  }
}

DI void phase_onorm(const Params& p, const Sub& s) {
  const int lane = VTID & 63, wave = VTID >> 6;
  const bf16_t* O = (const bf16_t*)(p.ws + W_SLOT0);
  const bf16_t* z1 = (const bf16_t*)(p.ws + W_SLOT1);
  bf16_t* on = (bf16_t*)(p.ws + W_SLOT2);
  const int stride = s.vg * 4, rhi = s.samp ? M : MP;
  float gpv[16];
#pragma unroll
  for (int i = 0; i < 16; ++i) gpv[i] = p.gdn_norm_g[(lane & 7) * 16 + i];
  for (int r = (s.samp ? MP : 0) + s.vb * 4 + wave; r < rhi; r += 2 * stride) {
    const bool two = r + stride < rhi;
    const int rr[2] = {r, two ? r + stride : r};
    float v[2][16], zz[2][16];
#pragma unroll
    for (int q = 0; q < 2; ++q) {
      const size_t o = (size_t)rr[q] * D + lane * 16;
#pragma unroll
      for (int i = 0; i < 4; ++i) { ld_bf4(O + o + i * 4, v[q][4 * i], v[q][4 * i + 1], v[q][4 * i + 2], v[q][4 * i + 3]); ld_bf4(z1 + o + i * 4, zz[q][4 * i], zz[q][4 * i + 1], zz[q][4 * i + 2], zz[q][4 * i + 3]); }
    }
#pragma unroll
    for (int q = 0; q < 2; ++q) {
      float ss = 0.f;
#pragma unroll
      for (int i = 0; i < 16; ++i) ss += v[q][i] * v[q][i];
      ss += __shfl_xor(ss, 1); ss += __shfl_xor(ss, 2); ss += __shfl_xor(ss, 4);
      const float rs = rsqrtf(ss * (1.0f / 128.f) + EPS);
      if (q == 0 || two) {
        const size_t o = (size_t)rr[q] * D + lane * 16;
        float w[16];
#pragma unroll
        for (int i = 0; i < 16; ++i) w[i] = v[q][i] * rs * gpv[i] * siluf_(zz[q][i]);
#pragma unroll
        for (int i = 0; i < 4; ++i) st_bf4(on + o + i * 4, w[4 * i], w[4 * i + 1], w[4 * i + 2], w[4 * i + 3]);
      }
    }
  }
}

DI void phase_final(const Params& p, const Sub& s) {
  const int lane = VTID & 63, wave = VTID >> 6;
  const int stride = s.vg * 4, rhi = s.samp ? M : MP;
  for (int r = (s.samp ? MP : 0) + s.vb * 4 + wave; r < rhi; r += 2 * stride) {
    const int rr[2] = {r, (r + stride < rhi) ? r + stride : r};
    const bool two = r + stride < rhi;
    float4 v[2][4], g4[4];
#pragma unroll
    for (int q = 0; q < 2; ++q) {
      const bf16_t* srcb = (const bf16_t*)(p.ws + W_SLOT3) + (size_t)rr[q] * D;
#pragma unroll
      for (int i = 0; i < 4; ++i) ld_bf4(srcb + i * 256 + lane * 4, v[q][i].x, v[q][i].y, v[q][i].z, v[q][i].w);
    }
#pragma unroll
    for (int i = 0; i < 4; ++i) g4[i] = *(const float4*)(p.final_g + i * 256 + lane * 4);
#pragma unroll
    for (int q = 0; q < 2; ++q) {
      float ss = 0.f;
#pragma unroll
      for (int i = 0; i < 4; ++i) ss += v[q][i].x * v[q][i].x + v[q][i].y * v[q][i].y + v[q][i].z * v[q][i].z + v[q][i].w * v[q][i].w;
      ss = wave_sum(ss);
      const float rs = rsqrtf(ss * (1.0f / D) + EPS);
      if (q == 0 || two) {
        float* dstp = p.out + (size_t)rr[q] * D;
#pragma unroll
        for (int i = 0; i < 4; ++i) {
          float4 o; o.x = v[q][i].x * rs * g4[i].x; o.y = v[q][i].y * rs * g4[i].y; o.z = v[q][i].z * rs * g4[i].z; o.w = v[q][i].w * rs * g4[i].w;
          *(float4*)(dstp + i * 256 + lane * 4) = o;
        }
      }
    }
  }
}


#define XB_TMO      128
#define XB_XCNT(j)  (256  + 64 * (j))
#define XB_XSUB(j)  (1280 + 64 * (j))
#define XB_XGEN(j)  (2304 + 64 * (j))
#define XB_TOP      3328
#define XB_TOPGEN   3392
#define XCD_BAR_WORDS 3456
#define XB_SUB 3456
#define XB_SPIN_CAP (1u << 18)
DI unsigned xb_ld(unsigned* p) { return __hip_atomic_load(p, __ATOMIC_RELAXED, __HIP_MEMORY_SCOPE_AGENT); }
DI unsigned xb_add(unsigned* p, unsigned v) { return __hip_atomic_fetch_add(p, v, __ATOMIC_RELAXED, __HIP_MEMORY_SCOPE_AGENT); }
DI unsigned xb_xcc_id() { return (unsigned)__builtin_amdgcn_s_getreg((3 << 11) | 20) & 0xFu; }
#define XB_SPIN(cond, bar) do { unsigned _sp = 0; while (cond) { __builtin_amdgcn_s_sleep(1); \
    if ((++_sp & 255u) == 0u) { if (xb_ld(&(bar)[XB_TMO])) break; if (_sp > XB_SPIN_CAP) { atomicAdd(&(bar)[XB_TMO], 1u); break; } } } } while (0)
struct XcdBarrier { unsigned* bar; unsigned x; volatile LAS unsigned* st; };
DI XcdBarrier xcd_barrier_post(unsigned* bar, volatile LAS unsigned* st) {
  XcdBarrier b; b.bar = bar; b.x = xb_xcc_id(); b.st = st;
  if (threadIdx.x == 0) (void)xb_add(&bar[XB_XCNT(b.x)], 1u);
  return b;
}
DI void xcd_barrier_complete(unsigned* bar, unsigned x, unsigned& nloc, unsigned& nx) {
  const unsigned G = gridDim.x * gridDim.y * gridDim.z;
  unsigned sum, cnt, mine, sp = 0u;
  for (;;) {
    sum = 0u; cnt = 0u; mine = 0u;
#pragma unroll
    for (unsigned j = 0; j < 16; ++j) { const unsigned c = xb_ld(&bar[XB_XCNT(j)]); sum += c; cnt += (c > 0u) ? 1u : 0u; mine = (j == x) ? c : mine; }
    if (sum == G) break;
    __builtin_amdgcn_s_sleep(1);
    if ((++sp & 255u) == 0u) { if (xb_ld(&bar[XB_TMO])) break; if (sp > XB_SPIN_CAP) { atomicAdd(&bar[XB_TMO], 1u); break; } }
  }
  nloc = mine > 0u ? mine : 1u; nx = cnt > 0u ? cnt : 1u;
}
DI void xcd_barrier(const XcdBarrier& b) {
  asm volatile("s_waitcnt vmcnt(0)" ::: "memory");
  __syncthreads();
  if (threadIdx.x == 0) {
    unsigned* bar = b.bar;
    __builtin_amdgcn_s_waitcnt(0);
    unsigned nloc = b.st[0], nx = b.st[1];
    if (nloc == 0u) { xcd_barrier_complete(bar, b.x, nloc, nx); b.st[0] = nloc; b.st[1] = nx; }
    const unsigned old = xb_add(&bar[XB_XSUB(b.x)], 1u);
    const unsigned gen = old / nloc;
    if (old + 1u == (gen + 1u) * nloc) {
      __builtin_amdgcn_fence(__ATOMIC_RELEASE, "agent");
      asm volatile("s_waitcnt vmcnt(0)" ::: "memory");
      const unsigned og = xb_add(&bar[XB_TOP], 1u);
      const unsigned tg = og / nx;
      if (og + 1u == (tg + 1u) * nx) xb_add(&bar[XB_TOPGEN], 1u);
      else XB_SPIN(xb_ld(&bar[XB_TOPGEN]) == tg, bar);
      __builtin_amdgcn_fence(__ATOMIC_ACQUIRE, "agent");
      xb_add(&bar[XB_XGEN(b.x)], 1u);
      asm volatile("s_waitcnt vmcnt(0)" ::: "memory");
    } else {
      XB_SPIN(xb_ld(&bar[XB_XGEN(b.x)]) == gen, bar);
      __builtin_amdgcn_fence(__ATOMIC_ACQUIRE, "agent");
      asm volatile("s_waitcnt vmcnt(0)" ::: "memory");
    }
  }
  __syncthreads();
}

#define AS4 __attribute__((address_space(4)))
DI void load_params(Params& q) {
#if defined(__HIP_DEVICE_COMPILE__)
  int off = 0; asm volatile("" : "+s"(off));
  q = *(const Params AS4*)((const char AS4*)__builtin_amdgcn_kernarg_segment_ptr() + off);
#endif
}
DI void sub_barrier(unsigned* bar, unsigned target) {
  asm volatile("s_waitcnt vmcnt(0)" ::: "memory");
  __syncthreads();
  if (threadIdx.x == 0) {
    __builtin_amdgcn_fence(__ATOMIC_RELEASE, "agent");
    asm volatile("s_waitcnt vmcnt(0)" ::: "memory");
    xb_add(&bar[XB_SUB], 1u);
    XB_SPIN(xb_ld(&bar[XB_SUB]) < target, bar);
    __builtin_amdgcn_fence(__ATOMIC_ACQUIRE, "agent");
    asm volatile("s_waitcnt vmcnt(0)" ::: "memory");
  }
  __syncthreads();
}

__global__ void __launch_bounds__(512, 1) fwd_megakernel(Params p) {
  __shared__ __attribute__((aligned(16))) char lds_all[LDS_BYTES];
#define lds (lds_all + ((otid() >> 8) << 16))
  cg::grid_group grid = cg::this_grid();
  __shared__ uint4 xb_words;
  if (threadIdx.x == 0) xb_words = make_uint4(0u, 0u, 0u, 0u);
  __syncthreads();
  { Params q; load_params(q); (void)xcd_barrier_post((unsigned*)(q.ws + W_BAR), (volatile LAS unsigned*)&xb_words); }
#define GSYNC() do { Params q_; load_params(q_); XcdBarrier b_; b_.bar = (unsigned*)(q_.ws + W_BAR); b_.x = xb_xcc_id(); b_.st = (volatile LAS unsigned*)&xb_words; xcd_barrier(b_); } while (0)
#define PSUB Sub{VBID, VGRID, false}
  if (gridDim.x > 65535u) grid.sync();
  for (int rep = 0; rep < REP_SETUP; ++rep) { { Params q; load_params(q); phase_setup(q, lds); } GSYNC(); }
  { Params q; load_params(q); phase_norm_mod(q, PSUB, 0, false, (bf16_t*)(q.ws + W_SLOT0)); phase_norm_mod(q, Sub{VBID, VGRID, true}, 0, false, (bf16_t*)(q.ws + W_SLOT0)); }
  GSYNC();
  for (int rep = 0; rep < REP_GEMM; ++rep) { { Params q; load_params(q); phase_g1(q, PSUB, lds_all); } GSYNC(); }
  for (int rep = 0; rep < REP_S5; ++rep) {
    { Params q; load_params(q); phase_s5_e(q, lds); }
    GSYNC();
    { Params q; load_params(q); phase_s5_scan(q); }
    GSYNC();
    { Params q; load_params(q); phase_s5_y(q, lds); }
    GSYNC();
  }
  for (int rep = 0; rep < REP_GEMM; ++rep) { { Params q; load_params(q); phase_g2(q, PSUB, lds_all); } GSYNC(); }
  for (int rep = 0; rep < REP_GEMM; ++rep) { { Params q; load_params(q); phase_gout(q, PSUB, lds_all, 0, (const bf16_t*)(q.ws + W_SLOT0), (const bf16_t*)(q.ws + W_S5OUT)); } GSYNC(); }
  { Params q; load_params(q); phase_norm_mod(q, PSUB, 1, true, (bf16_t*)(q.ws + W_SLOT0)); }
  GSYNC();
  for (int rep = 0; rep < REP_GEMM; ++rep) { { Params q; load_params(q); phase_g4(q, PSUB, lds_all); } GSYNC(); }
  for (int rep = 0; rep < REP_PREP; ++rep) { { Params q; load_params(q); phase_gdn_prep(q, PSUB, lds); } GSYNC(); }
  if (blockIdx.x < 128) {
    { Params q; load_params(q); phase_gdn_seq(q, Sub{0, 0, false}, lds_all); }
  } else {
    const int svb = (blockIdx.x - 128) * 2 + (otid() >> 8);
    unsigned tgt = 0;
#define SSUB Sub{svb, 256, true}
#define SSYNC() do { Params q_; load_params(q_); tgt += gridDim.x - 128; sub_barrier((unsigned*)(q_.ws + W_BAR), tgt); } while (0)
    { Params q; load_params(q); phase_g1(q, SSUB, lds_all); }
    SSYNC();
    { Params q; load_params(q); phase_s5_sample(q, SSUB); }
    SSYNC();
    { Params q; load_params(q); phase_g2(q, SSUB, lds_all); }
    SSYNC();
    { Params q; load_params(q); phase_gout(q, SSUB, lds_all, 0, (const bf16_t*)(q.ws + W_SLOT0), (const bf16_t*)(q.ws + W_S5OUT)); }
    SSYNC();
    { Params q; load_params(q); phase_norm_mod(q, SSUB, 1, true, (bf16_t*)(q.ws + W_SLOT0)); }
    SSYNC();
    { Params q; load_params(q); phase_g4(q, SSUB, lds_all); }
    SSYNC();
    { Params q; load_params(q); phase_gdn_prep(q, SSUB, lds); }
    SSYNC();
    { Params q; load_params(q); phase_gdn_seq(q, SSUB, lds_all); }
    SSYNC();
    { Params q; load_params(q); phase_onorm(q, SSUB); }
    SSYNC();
    { Params q; load_params(q); phase_gout(q, SSUB, lds_all, 1, (const bf16_t*)(q.ws + W_SLOT2), (const bf16_t*)(q.ws + W_GDNOUT)); }
  }
  GSYNC();
  { Params q; load_params(q); phase_onorm(q, PSUB); }
  GSYNC();
  { Params q; load_params(q); phase_gout(q, PSUB, lds_all, 1, (const bf16_t*)(q.ws + W_SLOT2), (const bf16_t*)(q.ws + W_GDNOUT)); }
  GSYNC();
  { Params q; load_params(q); phase_final(q, PSUB); phase_final(q, Sub{VBID, VGRID, true}); }
#undef lds
}

extern "C" void kernel_launch(void* const* d_in, const int* in_sizes, int n_in, void* d_out, int out_size, void* d_ws, size_t ws_size,
                              hipStream_t stream) {
  static int grid_blocks = 0;
  if (!grid_blocks) {
    int dev = 0, cus = 0, per_cu = 0;
    hipGetDevice(&dev);
    hipDeviceGetAttribute(&cus, hipDeviceAttributeMultiprocessorCount, dev);
    hipOccupancyMaxActiveBlocksPerMultiprocessor(&per_cu, fwd_megakernel, 512, 0);
    if (per_cu > 1) per_cu = 1;
    if (per_cu < 1) per_cu = 1;
    grid_blocks = cus * per_cu;
    grid_blocks &= ~7;
  }
  Params p{};
  const float** pp = (const float**)&p;
  for (int i = 0; i < 30; ++i) pp[i] = (const float*)d_in[i];
  p.out = (float*)d_out;
  p.ws = (char*)d_ws;
  hipMemsetAsync((char*)d_ws + W_BAR, 0, (XCD_BAR_WORDS + 64) * 4, stream);
  void* args[] = {&p};
  hipError_t e = hipLaunchCooperativeKernel((void*)fwd_megakernel, dim3(grid_blocks), dim3(512), args, 0, stream);
  if (e != hipSuccess) fprintf(stderr, "cooperative launch failed: %s (grid %d)\n", hipGetErrorString(e), grid_blocks);
}
```

```cpp
#include <hip/hip_runtime.h>
#include <hip/hip_cooperative_groups.h>
#include <cstdio>
namespace cg = cooperative_groups;

typedef unsigned short bf16_t;
typedef short bf16x8 __attribute__((ext_vector_type(8)));
typedef float f32x4 __attribute__((ext_vector_type(4)));
#define DI __device__ __forceinline__

constexpr int D = 1024;
constexpr int MP = 65536;
constexpr int MS = 256;
constexpr int M = MP + MS;
constexpr int NCH = 1040;
constexpr float EPS = 1e-6f;
constexpr int LDS_BYTES = 128 * 1024 + 2048;
#define REP_SETUP 1
#define REP_GEMM 1
#define REP_S5 1
#define REP_PREP 1
#define REP_SEQ 1

constexpr size_t O_Y = 0;
constexpr size_t O_S5RE_P = 67371008;
constexpr size_t O_S5IM_P = 67403776;
constexpr size_t O_GDN_P = 67436544;
constexpr size_t O_CONV_P = 68485120;
constexpr size_t O_S5RE_S = 68534272;
constexpr size_t O_S5IM_S = 68599808;
constexpr size_t O_GDN_S = 68665344;
constexpr size_t O_CONV_S = 70762496;

constexpr size_t MU = (size_t)M * 1024 * 2;
constexpr size_t W_S5IN = 0;
constexpr size_t W_GLU = 4194304;
constexpr size_t W_S5OUT = 6291456;
constexpr size_t W_GDNIN = 8388608;
constexpr size_t W_GDNOUT = 15204352;
constexpr size_t W_MOD = 17301504;
constexpr size_t W_BA = 17891328;
constexpr size_t W_USAMP = 22102016;
constexpr size_t W_ABAR = 23150592;
constexpr size_t W_A64 = 23183360;
constexpr size_t W_BBAR = 23216128;
constexpr size_t W_ZERO = 23740416;
constexpr size_t W_BAR = 23740672;
constexpr size_t W_SLOT0 = 25165824;
constexpr size_t W_SLOT1 = W_SLOT0 + MU;
constexpr size_t W_SLOT2 = W_SLOT1 + MU;
constexpr size_t W_SLOT3 = W_SLOT2 + MU;
constexpr size_t W_X = W_SLOT3 + MU;
constexpr size_t W_KTAB = W_X;
constexpr size_t W_ME = W_KTAB + 2097152;
constexpr size_t W_MC = W_ME + 16777216;
constexpr size_t W_E = W_MC + 16777216;
constexpr size_t W_H = W_E + 67108864;
constexpr size_t W_GW = W_X;
constexpr size_t W_GU = W_GW + (size_t)NCH * 8 * 64 * 128 * 2;
constexpr size_t W_GQK = W_GU + (size_t)NCH * 8 * 64 * 128 * 2;
constexpr size_t W_GQ = W_GQK + (size_t)NCH * 8 * 64 * 64 * 2;
constexpr size_t W_GKT = W_GQ + (size_t)NCH * 4 * 64 * 128 * 2;
constexpr size_t W_GGC = W_GKT + (size_t)NCH * 4 * 64 * 128 * 2;

struct Params {
  const float* x_prompt; const float* x_sample; const float* c_prompt; const float* c_sample;
  const float* st_s5_re; const float* st_s5_im; const float* st_gdn; const float* st_conv;
  const float* norm_g; const float* w_ada; const float* b_ada; const float* s5_w_in;
  const float* s5_log_step; const float* s5_lam_re; const float* s5_lam_im; const float* s5_b_re;
  const float* s5_b_im; const float* s5_c_re; const float* s5_c_im; const float* s5_d;
  const float* s5_w_glu; const float* s5_b_glu; const float* s5_w_out; const float* gdn_w_in;
  const float* gdn_conv_w; const float* gdn_a_log; const float* gdn_dt_bias; const float* gdn_norm_g;
  const float* gdn_w_out; const float* final_g;
  float* out; char* ws;
};

DI int otid() { int t = threadIdx.x; asm volatile("" : "+v"(t)); return t; }
#define VTID (otid() & 255)
#define VBID ((int)(blockIdx.x * 2 + (otid() >> 8)))
#define VGRID ((int)(gridDim.x * 2))
typedef __bf16 hwbf16x2 __attribute__((ext_vector_type(2)));
typedef float hwf32x2 __attribute__((ext_vector_type(2)));
DI bf16_t f2bf(float f) { const __bf16 r = (__bf16)f; return __builtin_bit_cast(bf16_t, r); }
DI float bf2f(bf16_t h) { return __uint_as_float(((unsigned)h) << 16); }
DI unsigned pack2(float a, float b) { const hwf32x2 v = {a, b}; const hwbf16x2 r = __builtin_convertvector(v, hwbf16x2); return __builtin_bit_cast(unsigned, r); }
DI float sigmoidf_(float x) { return __builtin_amdgcn_rcpf(1.0f + __expf(-x)); }
DI float siluf_(float x) { return x * sigmoidf_(x); }
DI float geluf_(float x) { return x * sigmoidf_(1.5957691216057308f * (x + 0.044715f * x * x * x)); }
DI float row16_sum(float v) {
  v += __int_as_float(__builtin_amdgcn_update_dpp(0, __float_as_int(v), 0xB1, 0xF, 0xF, true));
  v += __int_as_float(__builtin_amdgcn_update_dpp(0, __float_as_int(v), 0x4E, 0xF, 0xF, true));
  v += __int_as_float(__builtin_amdgcn_update_dpp(0, __float_as_int(v), 0x141, 0xF, 0xF, true));
  v += __int_as_float(__builtin_amdgcn_update_dpp(0, __float_as_int(v), 0x140, 0xF, 0xF, true));
  return v;
}
DI float wave_sum(float v) {
  v = row16_sum(v);
  v += __shfl_xor(v, 16); v += __shfl_xor(v, 32);
  return v;
}
DI float4 ldnt4(const float* p) { const f32x4 v = __builtin_nontemporal_load((const f32x4*)p); float4 r; r.x = v[0]; r.y = v[1]; r.z = v[2]; r.w = v[3]; return r; }
DI void stnt4(float* p, float4 o) { f32x4 v; v[0] = o.x; v[1] = o.y; v[2] = o.z; v[3] = o.w; __builtin_nontemporal_store(v, (f32x4*)p); }
DI int row_bi(int r) { return r < MP ? (r >> 13) : 8 + ((r - MP) >> 4); }
DI const float* xrow(const Params& p, int r) { return r < MP ? p.x_prompt + (size_t)r * D : p.x_sample + (size_t)(r - MP) * D; }
DI bf16x8 mkfrag(f32x4 a, f32x4 b) {
  typedef unsigned u32x4 __attribute__((ext_vector_type(4)));
  u32x4 v; v[0] = pack2(a[0], a[1]); v[1] = pack2(a[2], a[3]); v[2] = pack2(b[0], b[1]); v[3] = pack2(b[2], b[3]);
  return __builtin_bit_cast(bf16x8, v);
}
DI void lds_barrier() { asm volatile("s_waitcnt lgkmcnt(0)" ::: "memory"); __builtin_amdgcn_s_barrier(); asm volatile("" ::: "memory"); }
#define MFMA16(a, b, c) __builtin_amdgcn_mfma_f32_16x16x32_bf16((a), (b), (c), 0, 0, 0)

DI bf16x8 ldfrag(const char* base, int rowbytes, int row, int chunk) {
  return *(const bf16x8*)(base + row * rowbytes + ((chunk ^ (row & 7)) << 4));
}
DI bf16x8 ldfrag_perm(const char* base, int rowbytes, int row, int c, int fq) {
  typedef unsigned u32x2 __attribute__((ext_vector_type(2)));
  typedef unsigned u32x4 __attribute__((ext_vector_type(4)));
  const int ch0 = 4 * c + (fq >> 1), ch1 = ch0 + 2, off = (fq & 1) * 8;
  const u32x2 lo = *(const u32x2*)(base + row * rowbytes + ((ch0 ^ (row & 7)) << 4) + off);
  const u32x2 hi = *(const u32x2*)(base + row * rowbytes + ((ch1 ^ (row & 7)) << 4) + off);
  u32x4 v; v[0] = lo[0]; v[1] = lo[1]; v[2] = hi[0]; v[3] = hi[1];
  return __builtin_bit_cast(bf16x8, v);
}

DI int kperm(int k) { const int ki = k & 31; return (k & ~31) + ((ki & 15) >> 2) * 8 + (ki >> 4) * 4 + (ki & 3); }
DI int tile_remap(int L, int nt) {
  const int q = nt >> 3, r = nt & 7, xcd = L & 7, off = L >> 3;
  return (xcd < r ? xcd * (q + 1) : r * (q + 1) + (xcd - r) * q) + off;
}

#define LAS __attribute__((address_space(3)))
struct NoLoad {};
struct LdY { uint2 u; float4 d; };
template <class FA, class FB, class FL, class FS>
DI void gemm_tile(char* lds, int ksteps, int rot, FA fa, FB fb, FL fl, FS fs) {
  const int tid = VTID, lane = tid & 63, wave = tid >> 6;
  const int wr = wave >> 1, wc = wave & 1, fr = lane & 15, fq = lane >> 4;
  f32x4 acc[4][4];
#pragma unroll
  for (int m = 0; m < 4; ++m)
#pragma unroll
    for (int n = 0; n < 4; ++n) acc[m][n] = (f32x4){0.f, 0.f, 0.f, 0.f};
  LAS char* l3 = (LAS char*)lds;
#pragma unroll
  for (int i = 0; i < 4; ++i) {
    const int id = tid + i * 256, r = id >> 3, c = (id & 7) ^ (r & 7);
    __builtin_amdgcn_global_load_lds((const unsigned*)fa(r, rot * 8 + c), (LAS unsigned*)(l3 + id * 16), 16, 0, 0);
    __builtin_amdgcn_global_load_lds((const unsigned*)fb(r, rot * 8 + c), (LAS unsigned*)(l3 + 16384 + id * 16), 16, 0, 0);
  }
  asm volatile("s_waitcnt vmcnt(0)" ::: "memory");
  __syncthreads();
  for (int ks = 0; ks < ksteps; ++ks) {
    const int cur = ks & 1;
    if (ks + 1 < ksteps) {
      int kn = ks + 1 + rot; if (kn >= ksteps) kn -= ksteps;
      LAS char* dst = l3 + (cur ^ 1) * 32768;
#pragma unroll
      for (int i = 0; i < 4; ++i) {
        const int id = tid + i * 256, r = id >> 3, c = (id & 7) ^ (r & 7);
        __builtin_amdgcn_global_load_lds((const unsigned*)fa(r, kn * 8 + c), (LAS unsigned*)(dst + id * 16), 16, 0, 0);
        __builtin_amdgcn_global_load_lds((const unsigned*)fb(r, kn * 8 + c), (LAS unsigned*)(dst + 16384 + id * 16), 16, 0, 0);
      }
    }
    const char* A = lds + cur * 32768;
    const char* B = A + 16384;
#pragma unroll
    for (int kk = 0; kk < 2; ++kk) {
      bf16x8 af[4], bq[4];
#pragma unroll
      for (int m = 0; m < 4; ++m) af[m] = ldfrag(A, 128, wr * 64 + m * 16 + fr, kk * 4 + fq);
#pragma unroll
      for (int n = 0; n < 4; ++n) bq[n] = ldfrag(B, 128, wc * 64 + n * 16 + fr, kk * 4 + fq);
#pragma unroll
      for (int m = 0; m < 4; ++m)
#pragma unroll
        for (int n = 0; n < 4; ++n) acc[m][n] = MFMA16(bq[n], af[m], acc[m][n]);
    }
    asm volatile("s_waitcnt vmcnt(0)" ::: "memory");
    __syncthreads();
  }
  decltype(fl(0, 0)) ld[4][4];
#pragma unroll
  for (int m = 0; m < 4; ++m)
#pragma unroll
    for (int n = 0; n < 4; ++n) ld[m][n] = fl(wr * 64 + m * 16 + fr, wc * 64 + n * 16 + 4 * fq);
#pragma unroll
  for (int m = 0; m < 4; ++m)
#pragma unroll
    for (int n = 0; n < 4; ++n) fs(wr * 64 + m * 16 + fr, wc * 64 + n * 16 + 4 * fq, acc[m][n], ld[m][n]);
}
template <class FA, class FB, class FE>
DI void gemm_tile(char* lds, int ksteps, int rot, FA fa, FB fb, FE fe) {
  gemm_tile(lds, ksteps, rot, fa, fb, [](int, int) { return NoLoad{}; }, [&](int r, int c, f32x4 v, const NoLoad&) { fe(r, c, v); });
}

DI int lds_byte8(int r, int c) { const int st = (r >> 4) * 2 + (c >> 5), rr = r & 15, cc = c & 31, ob = rr * 64 + cc * 2; return st * 1024 + (ob ^ (((ob >> 9) & 1) << 5)); }
DI void stage_rc8(int b, int& R, int& C) { const int st = b / 1024, sb = b % 1024, swz = sb ^ (((sb >> 9) & 1) << 5); R = (st >> 1) * 16 + swz / 64; C = (st & 1) * 32 + (swz % 64) / 2; }
struct Ld2 { float4 a, b; };
template <class FL, class FS>
DI void gemm8_tile(char* shmc, const bf16_t* __restrict__ A, const bf16_t* __restrict__ Bt, const int K, const int brow, const int bcol, FL fl, FS fs) {
  constexpr int HT = 8192, HALF = 128;
  bf16_t* shm = (bf16_t*)shmc;
#define SA(b, h) (shm + ((b) * 2 + (h)) * HT)
#define SB(b, h) (shm + (4 + (b) * 2 + (h)) * HT)
#define STAGE(P, BASE, br, kt) do { const long _g = (long)(br) * K + (long)(kt) * 64; \
    _Pragma("unroll") for (int _i = 0; _i < 2; ++_i) { const int _b = tidx * 16 + _i * 8192; int _r, _c; stage_rc8(_b, _r, _c); \
      __builtin_amdgcn_global_load_lds((const unsigned*)(BASE + _g + (long)_r * K + _c), (LAS unsigned*)((LAS char*)(P) + _b), 16, 0, 0); } } while (0)
#define LDA(dst, b, h) _Pragma("unroll") for (int m = 0; m < 4; ++m) _Pragma("unroll") for (int k = 0; k < 2; ++k) \
    dst[m][k] = *reinterpret_cast<const bf16x8*>((const char*)SA(b, h) + lds_byte8(wr * 64 + m * 16 + fr, k * 32 + fq * 8))
#define LDB(dst, b, h) _Pragma("unroll") for (int n = 0; n < 2; ++n) _Pragma("unroll") for (int k = 0; k < 2; ++k) \
    dst[n][k] = *reinterpret_cast<const bf16x8*>((const char*)SB(b, h) + lds_byte8(wc * 32 + n * 16 + fr, k * 32 + fq * 8))
#define MMA(ai, bj, At_, Bt_) do { __builtin_amdgcn_s_setprio(1); \
    _Pragma("unroll") for (int m = 0; m < 4; ++m) _Pragma("unroll") for (int n = 0; n < 2; ++n) _Pragma("unroll") for (int k = 0; k < 2; ++k) \
      acc[ai][bj][m][n] = MFMA16(Bt_[n][k], At_[m][k], acc[ai][bj][m][n]); \
    __builtin_amdgcn_s_setprio(0); } while (0)
#define WAIT_V(n) asm volatile("s_waitcnt vmcnt(" #n ")" ::: "memory")
#define WAIT_L(n) asm volatile("s_waitcnt lgkmcnt(" #n ")" ::: "memory")
#define BAR __builtin_amdgcn_s_barrier()
#define SCHED __builtin_amdgcn_sched_barrier(0)
  const int tidx = otid();
  const int wid = tidx >> 6, lane = tidx & 63, wr = wid >> 2, wc = wid & 3, fr = lane & 15, fq = lane >> 4;
  f32x4 acc[2][2][4][2];
#pragma unroll
  for (int a = 0; a < 2; ++a)
#pragma unroll
    for (int b = 0; b < 2; ++b)
#pragma unroll
      for (int m = 0; m < 4; ++m)
#pragma unroll
        for (int n = 0; n < 2; ++n) acc[a][b][m][n] = (f32x4){0.f, 0.f, 0.f, 0.f};
  bf16x8 At[4][2], B0[2][2], B1[2][2];
  const int nt = K / 64;
  STAGE(SB(0, 0), Bt, bcol, 0); STAGE(SA(0, 0), A, brow, 0);
  STAGE(SB(0, 1), Bt, bcol + HALF, 0); STAGE(SA(0, 1), A, brow + HALF, 0);
  if (wr == 1) BAR;
  WAIT_V(4); BAR;
  STAGE(SB(1, 0), Bt, bcol, 1); STAGE(SA(1, 0), A, brow, 1); STAGE(SB(1, 1), Bt, bcol + HALF, 1);
  WAIT_V(6); BAR;
  for (int t = 0; t < nt - 2; t += 2) {
    LDB(B0, 0, 0); SCHED; LDA(At, 0, 0); STAGE(SA(1, 1), A, brow + HALF, t + 1);
    WAIT_L(8); BAR; WAIT_L(0); MMA(0, 0, At, B0); BAR; SCHED;
    LDB(B1, 0, 1); STAGE(SB(0, 0), Bt, bcol, t + 2);
    BAR; WAIT_L(0); MMA(0, 1, At, B1); BAR;
    LDA(At, 0, 1); STAGE(SA(0, 0), A, brow, t + 2);
    BAR; WAIT_L(0); MMA(1, 0, At, B0); BAR; SCHED;
    STAGE(SB(0, 1), Bt, bcol + HALF, t + 2);
    WAIT_V(6); BAR; MMA(1, 1, At, B1); BAR;
    LDB(B0, 1, 0); SCHED; LDA(At, 1, 0); STAGE(SA(0, 1), A, brow + HALF, t + 2);
    WAIT_L(8); BAR; WAIT_L(0); MMA(0, 0, At, B0); BAR; SCHED;
    LDB(B1, 1, 1); STAGE(SB(1, 0), Bt, bcol, t + 3);
    BAR; WAIT_L(0); MMA(0, 1, At, B1); BAR;
    LDA(At, 1, 1); STAGE(SA(1, 0), A, brow, t + 3);
    BAR; WAIT_L(0); MMA(1, 0, At, B0); BAR; SCHED;
    STAGE(SB(1, 1), Bt, bcol + HALF, t + 3);
    WAIT_V(6); BAR; MMA(1, 1, At, B1); BAR;
  }
  { LDB(B0, 0, 0); LDA(At, 0, 0); STAGE(SA(1, 1), A, brow + HALF, nt - 1);
    BAR; WAIT_L(0); MMA(0, 0, At, B0); BAR;
    LDB(B1, 0, 1); BAR; WAIT_L(0); MMA(0, 1, At, B1); BAR;
    LDA(At, 0, 1); WAIT_V(4); BAR; WAIT_L(0); MMA(1, 0, At, B0); MMA(1, 1, At, B1); BAR; }
  { LDB(B0, 1, 0); LDA(At, 1, 0); WAIT_V(2); BAR; WAIT_L(0); MMA(0, 0, At, B0); BAR;
    LDB(B1, 1, 1); WAIT_V(0); BAR; WAIT_L(0); MMA(0, 1, At, B1); BAR;
    LDA(At, 1, 1); BAR; WAIT_L(0); MMA(1, 0, At, B0); MMA(1, 1, At, B1); BAR; }
  if (wr == 0) BAR;
#pragma unroll
  for (int ai = 0; ai < 2; ++ai)
#pragma unroll
    for (int mh = 0; mh < 2; ++mh) {
      decltype(fl(0, 0)) ld[2][2][2];
#pragma unroll
      for (int mm = 0; mm < 2; ++mm)
#pragma unroll
        for (int bj = 0; bj < 2; ++bj)
#pragma unroll
          for (int n = 0; n < 2; ++n) ld[mm][bj][n] = fl(brow + ai * HALF + wr * 64 + (2 * mh + mm) * 16 + fr, bcol + bj * HALF + wc * 32 + n * 16 + 4 * fq);
#pragma unroll
      for (int mm = 0; mm < 2; ++mm)
#pragma unroll
        for (int bj = 0; bj < 2; ++bj)
#pragma unroll
          for (int n = 0; n < 2; ++n) fs(brow + ai * HALF + wr * 64 + (2 * mh + mm) * 16 + fr, bcol + bj * HALF + wc * 32 + n * 16 + 4 * fq, acc[ai][bj][2 * mh + mm][n], ld[mm][bj][n]);
    }
  asm volatile("s_waitcnt vmcnt(0)" ::: "memory");
  __syncthreads();
#undef SA
#undef SB
#undef STAGE
#undef LDA
#undef LDB
#undef MMA
}
DI void tile8_order(int L, int nM, int nN, int& pm, int& pn) {
  const int t = tile_remap(L, nM * nN), nig = 8 * nN, gid = t / nig, fm = gid * 8, gsz = (nM - fm) < 8 ? (nM - fm) : 8;
  pm = fm + ((t % nig) % gsz); pn = (t % nig) / gsz;
}

DI void st_bf4(bf16_t* p, float a, float b, float c, float d) { uint2 v; v.x = pack2(a, b); v.y = pack2(c, d); *(uint2*)p = v; }
DI void ld_bf4(const bf16_t* p, float& a, float& b, float& c, float& d) {
  const uint2 v = *(const uint2*)p; a = __uint_as_float(v.x << 16); b = __uint_as_float(v.x & 0xffff0000u); c = __uint_as_float(v.y << 16); d = __uint_as_float(v.y & 0xffff0000u);
}

struct Sub { int vb, vg; bool samp; };
template <class FL, class FS>
DI void gemm_dispatch(const Sub& s, char* lds_all, const bf16_t* A, const bf16_t* Bt, const int nN256, FL fl, FS fs) {
  if (!s.samp) {
    const int nM = 256;
    for (int L = blockIdx.x; L < nM * nN256; L += gridDim.x) {
      int pm, pn; tile8_order(L, nM, nN256, pm, pn);
      gemm8_tile(lds_all, A, Bt, D, pm * 256, pn * 256, fl, fs);
    }
  } else {
    char* ldsh = lds_all + ((otid() >> 8) << 16);
    const int nN = nN256 * 2, nt = 2 * nN;
    for (int k_ = 0; k_ * s.vg < nt; ++k_) {
      int t = k_ * s.vg + s.vb;
      if (k_ * s.vg + (s.vb & ~1) >= nt) continue;
      if (t >= nt) t = nt - 1;
      const int row0 = MP + (t / nN) * 128, col0 = (t % nN) * 128;
      gemm_tile(ldsh, 16, 0,
        [&](int r, int kc) { return A + (size_t)(row0 + r) * D + kc * 8; },
        [&](int n, int kc) { return Bt + (size_t)(col0 + n) * D + kc * 8; },
        [&](int r, int c, f32x4 v) { fs(row0 + r, col0 + c, v, fl(row0 + r, col0 + c)); });
    }
  }
}

DI void phase_setup(const Params& p, char* lds) {
  const int tid = VTID;
  if (VBID == 0 && tid < 16) ((unsigned*)(p.ws + W_ZERO))[tid] = 0u;
  const int NITEM = 384 + 2112 + 256;
  for (int k_ = 0; k_ * VGRID < (NITEM); ++k_) {
    int it = k_ * VGRID + VBID; const bool active_ = it < (NITEM); if (!active_) it = (NITEM) - 1;
    if (it < 384) {
      const int layer = it / 192, cc = it % 192, col = tid & 15, kp = tid >> 4;
      float* cs = (float*)lds;
      float acc[24];
#pragma unroll
      for (int i = 0; i < 24; ++i) acc[i] = 0.f;
      for (int kh = 0; kh < 2; ++kh) {
        __syncthreads();
        for (int idx = tid; idx < 24 * 512; idx += 256) {
          const int bi = idx >> 9, k = kh * 512 + (idx & 511);
          const float c = bi < 8 ? p.c_prompt[bi * D + k] : p.c_sample[(bi - 8) * D + k];
          cs[idx] = c / (1.0f + expf(-c));
        }
        __syncthreads();
        const float* wp = p.w_ada + ((size_t)layer * D + kh * 512 + kp * 32) * 3072 + cc * 16 + col;
#pragma unroll
        for (int k8 = 0; k8 < 32; k8 += 8) {
          float w[8];
#pragma unroll
          for (int u = 0; u < 8; ++u) w[u] = wp[(size_t)(k8 + u) * 3072];
#pragma unroll
          for (int bi = 0; bi < 24; ++bi) {
            const float4 c0 = *(const float4*)(cs + bi * 512 + kp * 32 + k8), c1 = *(const float4*)(cs + bi * 512 + kp * 32 + k8 + 4);
            acc[bi] += c0.x * w[0] + c0.y * w[1] + c0.z * w[2] + c0.w * w[3] + c1.x * w[4] + c1.y * w[5] + c1.z * w[6] + c1.w * w[7];
          }
        }
      }
      __syncthreads();
      float* red = (float*)lds;
#pragma unroll
      for (int bi = 0; bi < 24; ++bi) red[(kp * 24 + bi) * 16 + col] = acc[bi];
      __syncthreads();
      float* mod = (float*)(p.ws + W_MOD);
      for (int idx = tid; idx < 24 * 16; idx += 256) {
        const int bi = idx >> 4, c2 = idx & 15;
        float s = 0.f;
#pragma unroll
        for (int q = 0; q < 16; ++q) s += red[(q * 24 + bi) * 16 + c2];
        mod[(size_t)(bi * 2 + layer) * 3072 + cc * 16 + c2] = s + p.b_ada[layer * 3072 + cc * 16 + c2];
      }
      __syncthreads();
    } else if (it < 384 + 2112) {
      int t = it - 384;
      const float* W; bf16_t* Wt; int N, ntn;
      if (t < 512) { W = p.s5_w_in; Wt = (bf16_t*)(p.ws + W_S5IN); N = 2048; ntn = 32; }
      else if (t < 768) { t -= 512; W = p.s5_w_glu; Wt = (bf16_t*)(p.ws + W_GLU); N = 1024; ntn = 16; }
      else if (t < 1024) { t -= 768; W = p.s5_w_out; Wt = (bf16_t*)(p.ws + W_S5OUT); N = 1024; ntn = 16; }
      else if (t < 1856) { t -= 1024; W = p.gdn_w_in; Wt = (bf16_t*)(p.ws + W_GDNIN); N = 3088; ntn = 52; }
      else { t -= 1856; W = p.gdn_w_out; Wt = (bf16_t*)(p.ws + W_GDNOUT); N = 1024; ntn = 16; }
      const int tk = t / ntn, tn = t % ntn, k0 = tk * 64, n0 = tn * 64;
      float* tl = (float*)lds;
      const int tx = tid & 63, ty = tid >> 6;
#pragma unroll 4
      for (int i = 0; i < 16; ++i) {
        const int k = k0 + ty * 16 + i, n = n0 + tx;
        tl[(ty * 16 + i) * 65 + tx] = (n < N) ? W[(size_t)k * N + n] : 0.f;
      }
      __syncthreads();
#pragma unroll 4
      for (int i = 0; i < 16; ++i) {
        const int n = n0 + ty * 16 + i, k = k0 + tx;
        Wt[(size_t)n * 1024 + k] = f2bf(tl[tx * 65 + ty * 16 + i]);
      }
      __syncthreads();
    } else {
      const int t = it - 384 - 2112, g = t >> 2, d0 = (t & 3) * 8;
      float* sm = (float*)lds;
      float* Cr = sm; float* Ci = sm + 1024; float* Bbr = sm + 2048; float* Bbi = sm + 3072;
      float* Apr = sm + 4096; float* Api = sm + 4672; float* Wr = sm + 5248; float* Wi = sm + 6272;
      const float step = expf(p.s5_log_step[g]);
#pragma unroll
      for (int q = 0; q < 4; ++q) { const int idx = tid + q * 256; Cr[idx] = p.s5_c_re[g * 1024 + idx]; Ci[idx] = p.s5_c_im[g * 1024 + idx]; }
      if (tid < 64) {
        const int pp = tid;
        const float lr = p.s5_lam_re[g * 64 + pp], li = p.s5_lam_im[g * 64 + pp];
        const float mag = expf(lr * step);
        float sn, cn; sincosf(li * step, &sn, &cn);
        const float ar = mag * cn, ai = mag * sn;
        const float den = lr * lr + li * li, xr = ar - 1.0f;
        const float nr = (xr * lr + ai * li) / den, ni = (ai * lr - xr * li) / den;
#pragma unroll
        for (int c = 0; c < 16; ++c) {
          const float br = p.s5_b_re[(g * 64 + pp) * 16 + c], bi = p.s5_b_im[(g * 64 + pp) * 16 + c];
          Bbr[pp * 16 + c] = nr * br - ni * bi; Bbi[pp * 16 + c] = nr * bi + ni * br;
        }
        if (d0 == 0) {
          float* abar = (float*)(p.ws + W_ABAR);
          abar[(g * 64 + pp) * 2] = ar; abar[(g * 64 + pp) * 2 + 1] = ai;
          float* bb = (float*)(p.ws + W_BBAR);
#pragma unroll
          for (int c = 0; c < 16; ++c) {
            const float br = p.s5_b_re[(g * 64 + pp) * 16 + c], bi = p.s5_b_im[(g * 64 + pp) * 16 + c];
            bb[((g * 64 + pp) * 16 + c) * 2] = nr * br - ni * bi;
            bb[((g * 64 + pp) * 16 + c) * 2 + 1] = nr * bi + ni * br;
          }
        }
      }
#pragma unroll
      for (int q = 0; q < 3; ++q) {
        const int idx = tid + q * 256;
        if (idx < 576) {
          const int dd = idx >> 6, pp = idx & 63;
          const float lr = p.s5_lam_re[g * 64 + pp], li = p.s5_lam_im[g * 64 + pp];
          const float fd = (float)(d0 + dd);
          float s0, c0; sincosf(li * step * fd, &s0, &c0);
          const float m0 = expf(lr * step * fd);
          Apr[idx] = m0 * c0; Api[idx] = m0 * s0;
          if (d0 + dd == 32) { float* a64 = (float*)(p.ws + W_A64); a64[(g * 64 + pp) * 2] = m0 * c0; a64[(g * 64 + pp) * 2 + 1] = m0 * s0; }
        }
      }
      __syncthreads();
      bf16_t* ME = (bf16_t*)(p.ws + W_ME);
      bf16_t* MC = (bf16_t*)(p.ws + W_MC);
      bf16_t* KTb = (bf16_t*)(p.ws + W_KTAB);
      for (int dd = 0; dd < 8; ++dd) {
        const int d = d0 + dd;
#pragma unroll
        for (int q = 0; q < 4; ++q) {
          const int idx = tid + q * 256, pp = idx >> 4, c = idx & 15;
          const float ar = Apr[dd * 64 + pp], ai = Api[dd * 64 + pp], br = Bbr[idx], bi = Bbi[idx];
          const float wr_ = ar * br - ai * bi, wi_ = ar * bi + ai * br;
          Wr[idx] = wr_; Wi[idx] = wi_;
          ME[((size_t)(g * 128 + pp)) * 512 + (31 - d) * 16 + c] = f2bf(wr_);
          ME[((size_t)(g * 128 + 64 + pp)) * 512 + (31 - d) * 16 + c] = f2bf(wi_);
        }
        __syncthreads();
        {
          const int co = tid >> 4, ci = tid & 15;
          float s0 = 0.f, s1 = 0.f;
#pragma unroll 8
          for (int pp = 0; pp < 64; pp += 2) {
            s0 += Cr[co * 64 + pp] * Wr[pp * 16 + ci] - Ci[co * 64 + pp] * Wi[pp * 16 + ci];
            s1 += Cr[co * 64 + pp + 1] * Wr[(pp + 1) * 16 + ci] - Ci[co * 64 + pp + 1] * Wi[(pp + 1) * 16 + ci];
          }
          KTb[((size_t)(g * 16 + co) * 32 + d) * 16 + ci] = f2bf(s0 + s1);
        }
#pragma unroll
        for (int q = 0; q < 8; ++q) {
          const int idx = tid + q * 256, co = idx >> 7, k = idx & 127, pp = k & 63;
          const float cr = Cr[co * 64 + pp], cim = Ci[co * 64 + pp];
          const float a1r = Apr[(dd + 1) * 64 + pp], a1i = Api[(dd + 1) * 64 + pp];
          const float v = (k < 64) ? (cr * a1r - cim * a1i) : -(cr * a1i + cim * a1r);
          MC[((size_t)(g * 512 + d * 16 + co)) * 128 + k] = f2bf(v);
        }
        __syncthreads();
      }
    }
  }
}

DI void phase_norm_mod(const Params& p, const Sub& s, int layer, bool from_out, bf16_t* dst) {
  const int lane = VTID & 63, wave = VTID >> 6;
  const float* mod = (const float*)(p.ws + W_MOD);
  const float* gv = p.norm_g + layer * D;
  const int stride = s.vg * 4, rhi = s.samp ? M : MP;
  for (int r = (s.samp ? MP : 0) + s.vb * 4 + wave; r < rhi; r += 2 * stride) {
    const int rr[2] = {r, (r + stride < rhi) ? r + stride : r};
    const bool two = r + stride < rhi;
    float4 v[2][4], g4[4], sh[2][4], sc[2][4];
#pragma unroll
    for (int q = 0; q < 2; ++q) {
      if (from_out) {
        const bf16_t* srcb = (const bf16_t*)p.out + (size_t)rr[q] * D;
#pragma unroll
        for (int i = 0; i < 4; ++i) ld_bf4(srcb + i * 256 + lane * 4, v[q][i].x, v[q][i].y, v[q][i].z, v[q][i].w);
      } else {
        const float* src = xrow(p, rr[q]);
#pragma unroll
        for (int i = 0; i < 4; ++i) v[q][i] = ldnt4(src + i * 256 + lane * 4);
      }
      const float* mrow = mod + (size_t)(row_bi(rr[q]) * 2 + layer) * 3072;
#pragma unroll
      for (int i = 0; i < 4; ++i) { const int c = i * 256 + lane * 4; sh[q][i] = *(const float4*)(mrow + c); sc[q][i] = *(const float4*)(mrow + 1024 + c); }
    }
#pragma unroll
    for (int i = 0; i < 4; ++i) g4[i] = *(const float4*)(gv + i * 256 + lane * 4);
#pragma unroll
    for (int q = 0; q < 2; ++q) {
      float ss = 0.f;
#pragma unroll
      for (int i = 0; i < 4; ++i) ss += v[q][i].x * v[q][i].x + v[q][i].y * v[q][i].y + v[q][i].z * v[q][i].z + v[q][i].w * v[q][i].w;
      ss = wave_sum(ss);
      const float rs = rsqrtf(ss * (1.0f / D) + EPS);
      if (q == 0 || two) {
#pragma unroll
        for (int i = 0; i < 4; ++i) {
          const int c = i * 256 + lane * 4;
          st_bf4(dst + (size_t)rr[q] * D + c, v[q][i].x * rs * g4[i].x * (1.f + sc[q][i].x) + sh[q][i].x, v[q][i].y * rs * g4[i].y * (1.f + sc[q][i].y) + sh[q][i].y,
                 v[q][i].z * rs * g4[i].z * (1.f + sc[q][i].z) + sh[q][i].z, v[q][i].w * rs * g4[i].w * (1.f + sc[q][i].w) + sh[q][i].w);
        }
      }
    }
  }
}

DI void phase_g1(const Params& p, const Sub& s, char* lds_all) {
  const bf16_t* A = (const bf16_t*)(p.ws + W_SLOT0);
  const bf16_t* Bt = (const bf16_t*)(p.ws + W_S5IN);
  bf16_t* ugm = (bf16_t*)(p.ws + W_SLOT1);
  bf16_t* z = (bf16_t*)(p.ws + W_SLOT2);
  float* us = (float*)(p.ws + W_USAMP);
  {
    gemm_dispatch(s, lds_all, A, Bt, 8,
      [&](int, int) { return NoLoad{}; },
      [&](int row, int col, f32x4 v, const NoLoad&) {
        if (col < 1024) {
          if (row < MP) st_bf4(ugm + ((size_t)(col >> 4) * MP + row) * 16 + (col & 15), v[0], v[1], v[2], v[3]);
          else *(f32x4*)(us + (size_t)(row - MP) * D + col) = v;
        } else st_bf4(z + (size_t)row * D + (col - 1024), v[0], v[1], v[2], v[3]);
      });
  }
}

DI void phase_s5_e(const Params& p, char* lds) {
  const bf16_t* ugm = (const bf16_t*)(p.ws + W_SLOT1);
  const bf16_t* ME = (const bf16_t*)(p.ws + W_ME);
  float* E = (float*)(p.ws + W_E);
  const int nt = 64 * 16;
  for (int k_ = 0; k_ * VGRID < (nt); ++k_) {
    int L = k_ * VGRID + VBID; const bool active_ = L < (nt); if (!active_) L = (nt) - 1;
    const int g = L >> 4, mt = L & 15;
    const bf16_t* Ag = ugm + (size_t)g * MP * 16 + (size_t)mt * 128 * 512;
    gemm_tile(lds, 8, mt & 7,
      [&](int r, int kc) { return Ag + (size_t)r * 512 + kc * 8; },
      [&](int n, int kc) { return ME + (size_t)(g * 128 + n) * 512 + kc * 8; },
      [&](int r, int c, f32x4 v) { *(f32x4*)(E + ((size_t)g * 2048 + mt * 128 + r) * 128 + c) = v; });
  }
}

DI void phase_s5_sample(const Params& p, const Sub& s) {
  const int lane = VTID & 63, wave = VTID >> 6;
  const float* us = (const float*)(p.ws + W_USAMP);
  const float* abar = (const float*)(p.ws + W_ABAR);
  const float* bb = (const float*)(p.ws + W_BBAR);
  bf16_t* yg = (bf16_t*)(p.ws + W_SLOT3);
  for (int it = s.vb * 4 + wave; it < 1024; it += s.vg * 4) {
    const int b = it >> 6, g = it & 63;
    float xr = p.st_s5_re[(b * 64 + g) * 64 + lane], xi = p.st_s5_im[(b * 64 + g) * 64 + lane];
    const float ar = abar[(g * 64 + lane) * 2], ai = abar[(g * 64 + lane) * 2 + 1];
    float bbr[16], bbi[16], cr[16], ci[16];
#pragma unroll
    for (int c = 0; c < 16; ++c) {
      bbr[c] = bb[((g * 64 + lane) * 16 + c) * 2]; bbi[c] = bb[((g * 64 + lane) * 16 + c) * 2 + 1];
      cr[c] = p.s5_c_re[(g * 16 + c) * 64 + lane]; ci[c] = p.s5_c_im[(g * 16 + c) * 64 + lane];
    }
    const float dch = p.s5_d[g * 16 + (lane & 15)];
    for (int t = 0; t < 16; ++t) {
      const float* up = us + (size_t)(b * 16 + t) * D + g * 16;
      float br = 0.f, bi = 0.f;
#pragma unroll
      for (int c = 0; c < 16; ++c) { const float u = up[c]; br += bbr[c] * u; bi += bbi[c] * u; }
      const float nxr = ar * xr - ai * xi + br, nxi = ar * xi + ai * xr + bi;
      xr = nxr; xi = nxi;
      float yv = 0.f;
#pragma unroll
      for (int c = 0; c < 16; ++c) { const float s = wave_sum(cr[c] * xr - ci[c] * xi); if (lane == c) yv = s; }
      if (lane < 16) {
        const float u = up[lane];
        yg[(size_t)(MP + b * 16 + t) * D + g * 16 + lane] = f2bf(geluf_(yv + dch * u));
      }
    }
    p.out[O_S5RE_S + (b * 64 + g) * 64 + lane] = xr;
    p.out[O_S5IM_S + (b * 64 + g) * 64 + lane] = xi;
  }
}

DI void phase_s5_scan(const Params& p) {
  const float* E = (const float*)(p.ws + W_E);
  const float* a64 = (const float*)(p.ws + W_A64);
  bf16_t* H = (bf16_t*)(p.ws + W_H);
  for (int idx = VBID * 256 + VTID; idx < 8 * 64 * 64; idx += VGRID * 256) {
    const int pp = idx & 63, g = (idx >> 6) & 63, b = idx >> 12;
    const float ar = a64[(g * 64 + pp) * 2], ai = a64[(g * 64 + pp) * 2 + 1];
    float hr = 0.f, hi = 0.f;
    const size_t base = ((size_t)g * 2048 + b * 256) * 128;
    for (int n0 = 0; n0 < 256; n0 += 8) {
      float er[8], ei[8];
#pragma unroll
      for (int k = 0; k < 8; ++k) { er[k] = E[base + (size_t)(n0 + k) * 128 + pp]; ei[k] = E[base + (size_t)(n0 + k) * 128 + 64 + pp]; }
#pragma unroll
      for (int k = 0; k < 8; ++k) {
        H[base + (size_t)(n0 + k) * 128 + pp] = f2bf(hr); H[base + (size_t)(n0 + k) * 128 + 64 + pp] = f2bf(hi);
        const float nr = ar * hr - ai * hi + er[k], ni = ar * hi + ai * hr + ei[k];
        hr = nr; hi = ni;
      }
    }
    p.out[O_S5RE_P + (b * 64 + g) * 64 + pp] = hr;
    p.out[O_S5IM_P + (b * 64 + g) * 64 + pp] = hi;
  }
}

DI void phase_s5_y(const Params& p, char* lds) {
  const bf16_t* ugm = (const bf16_t*)(p.ws + W_SLOT1);
  const bf16_t* H = (const bf16_t*)(p.ws + W_H);
  const bf16_t* MC = (const bf16_t*)(p.ws + W_MC);
  const bf16_t* KT = (const bf16_t*)(p.ws + W_KTAB);
  bf16_t* yg = (bf16_t*)(p.ws + W_SLOT3);
  const bf16_t* zblk = (const bf16_t*)(p.ws + W_ZERO);
  const int nt = 64 * 8 * 8;
  for (int k_ = 0; k_ * VGRID < (nt); ++k_) {
    int L = k_ * VGRID + VBID; const bool active_ = L < (nt); if (!active_) L = (nt) - 1;
    const int j = 3 - (L >> 10), rem = L & 1023, g = rem >> 4, mt = rem & 15;
    const bf16_t* Ug = ugm + (size_t)g * MP * 16 + (size_t)mt * 128 * 512;
    const bf16_t* Hg = H + ((size_t)g * 2048 + mt * 128) * 128;
    gemm_tile(lds, 2 + 2 * (j + 1), 0,
      [&](int r, int kc) { return kc < 16 ? Hg + (size_t)r * 128 + kc * 8 : Ug + (size_t)r * 512 + (kc - 16) * 8; },
      [&](int n, int kc) {
        const int nn = j * 128 + n;
        if (kc < 16) return MC + ((size_t)g * 512 + nn) * 128 + kc * 8;
        const int t = nn >> 4, co = nn & 15, kk = (kc - 16) * 8, s = kk >> 4, ci0 = kk & 15;
        if (s > t) return zblk;
        return KT + ((size_t)(g * 16 + co) * 32 + (t - s)) * 16 + ci0;
      },
      [&](int r, int c) {
        const int nn = j * 128 + c, t = nn >> 4, co = nn & 15, cr = mt * 128 + r;
        const size_t tok = (size_t)cr * 32 + t;
        LdY l; l.u = *(const uint2*)(ugm + ((size_t)g * MP + tok) * 16 + co); l.d = *(const float4*)(p.s5_d + g * 16 + co);
        return l;
      },
      [&](int r, int c, f32x4 v, const LdY& ly) {
        const uint2 uu = ly.u;
        const int nn = j * 128 + c, t = nn >> 4, co = nn & 15, cr = mt * 128 + r;
        const size_t tok = (size_t)cr * 32 + t;
        const float u0 = __uint_as_float(uu.x << 16), u1 = __uint_as_float(uu.x & 0xffff0000u), u2 = __uint_as_float(uu.y << 16), u3 = __uint_as_float(uu.y & 0xffff0000u);
        const float4 d4 = ly.d;
        st_bf4(yg + tok * D + g * 16 + co, geluf_(v[0] + d4.x * u0), geluf_(v[1] + d4.y * u1), geluf_(v[2] + d4.z * u2), geluf_(v[3] + d4.w * u3));
      });
  }
}

DI void phase_g2(const Params& p, const Sub& s, char* lds_all) {
  const bf16_t* A = (const bf16_t*)(p.ws + W_SLOT3);
  const bf16_t* Bt = (const bf16_t*)(p.ws + W_GLU);
  const bf16_t* z = (const bf16_t*)(p.ws + W_SLOT2);
  bf16_t* y2 = (bf16_t*)(p.ws + W_SLOT0);
  {
    gemm_dispatch(s, lds_all, A, Bt, 4,
      [&](int row, int col) { const size_t o = (size_t)row * D + col; Ld2 r; const uint2 a = *(const uint2*)(A + o), b = *(const uint2*)(z + o);
        r.a.x = __uint_as_float(a.x); r.a.y = __uint_as_float(a.y); r.a.z = __uint_as_float(b.x); r.a.w = __uint_as_float(b.y); r.b = *(const float4*)(p.s5_b_glu + col); return r; },
      [&](int row, int col, f32x4 v, const Ld2& l2) {
        uint4 ld; ld.x = __float_as_uint(l2.a.x); ld.y = __float_as_uint(l2.a.y); ld.z = __float_as_uint(l2.a.z); ld.w = __float_as_uint(l2.a.w);
        const size_t o = (size_t)row * D + col;
        const float y0 = __uint_as_float(ld.x << 16), y1 = __uint_as_float(ld.x & 0xffff0000u), y2_ = __uint_as_float(ld.y << 16), y3 = __uint_as_float(ld.y & 0xffff0000u);
        const float z0 = __uint_as_float(ld.z << 16), z1 = __uint_as_float(ld.z & 0xffff0000u), z2 = __uint_as_float(ld.w << 16), z3 = __uint_as_float(ld.w & 0xffff0000u);
        const float4 b4 = l2.b;
        st_bf4(y2 + o, y0 * sigmoidf_(v[0] + b4.x) * siluf_(z0), y1 * sigmoidf_(v[1] + b4.y) * siluf_(z1),
               y2_ * sigmoidf_(v[2] + b4.z) * siluf_(z2), y3 * sigmoidf_(v[3] + b4.w) * siluf_(z3));
      });
  }
}

DI void phase_gout(const Params& p, const Sub& s, char* lds_all, int layer, const bf16_t* A, const bf16_t* Bt) {
  const float* mod = (const float*)(p.ws + W_MOD);
  {
    gemm_dispatch(s, lds_all, A, Bt, 4,
      [&](int row, int col) {
        const bf16_t* x1b = (const bf16_t*)p.out;
        float4 x4;
        if (layer == 0) x4 = ldnt4(xrow(p, row) + col);
        else ld_bf4(x1b + (size_t)row * D + col, x4.x, x4.y, x4.z, x4.w);
        Ld2 r; r.a = x4; r.b = *(const float4*)(mod + (size_t)(row_bi(row) * 2 + layer) * 3072 + 2048 + col);
        return r;
      },
      [&](int row, int col, f32x4 v, const Ld2& l2) {
        const float4 x4 = l2.a, g4 = l2.b;
        bf16_t* x1b = (bf16_t*)p.out;
        bf16_t* x2b = (bf16_t*)(p.ws + W_SLOT3);
        st_bf4((layer == 0 ? x1b : x2b) + (size_t)row * D + col, x4.x + g4.x * v[0], x4.y + g4.y * v[1], x4.z + g4.z * v[2], x4.w + g4.w * v[3]);
      });
  }
}

DI void phase_g4(const Params& p, const Sub& s, char* lds_all) {
  const bf16_t* A = (const bf16_t*)(p.ws + W_SLOT0);
  const bf16_t* Bt = (const bf16_t*)(p.ws + W_GDNIN);
  bf16_t* qkv = (bf16_t*)(p.ws + W_SLOT2);
  bf16_t* z1 = (bf16_t*)(p.ws + W_SLOT1);
  float* ba = (float*)(p.ws + W_BA);
  {
    gemm_dispatch(s, lds_all, A, Bt, s.samp ? 13 : 12,
      [&](int, int) { return NoLoad{}; },
      [&](int row, int col, f32x4 v, const NoLoad&) {
        if (col < 2048) {
          st_bf4(qkv + (size_t)row * 2048 + col, v[0], v[1], v[2], v[3]);
          if (row < MP) { const int l = row & 8191; if (l >= 8189) *(f32x4*)(p.out + O_CONV_P + ((size_t)(row >> 13) * 3 + (l - 8189)) * 2048 + col) = v; }
          else { const int l = (row - MP) & 15; if (l >= 13) *(f32x4*)(p.out + O_CONV_S + ((size_t)((row - MP) >> 4) * 3 + (l - 13)) * 2048 + col) = v; }
        } else if (col < 3072) st_bf4(z1 + (size_t)row * D + (col - 2048), v[0], v[1], v[2], v[3]);
        else if (col < 3088) *(f32x4*)(ba + (size_t)row * 16 + (col - 3072)) = v;
      });
  }
  if (!s.samp) {
    const int tidx = otid(), wid = tidx >> 6, lane = tidx & 63, fr = lane & 15, fq = lane >> 4;
    for (int rt = blockIdx.x; rt < 256; rt += gridDim.x) {
      const int r0 = rt * 256 + wid * 32;
      const bf16_t* a0p = A + (size_t)(r0 + fr) * D + fq * 8;
      const bf16_t* a1p = a0p + (size_t)16 * D;
      const bf16_t* bp = Bt + (size_t)(3072 + fr) * D + fq * 8;
      f32x4 c0 = (f32x4){0.f, 0.f, 0.f, 0.f}, c1 = (f32x4){0.f, 0.f, 0.f, 0.f};
#pragma unroll 8
      for (int ks = 0; ks < 32; ++ks) {
        const bf16x8 bb = *(const bf16x8*)(bp + ks * 32);
        const bf16x8 x0 = *(const bf16x8*)(a0p + ks * 32), x1 = *(const bf16x8*)(a1p + ks * 32);
        c0 = MFMA16(bb, x0, c0); c1 = MFMA16(bb, x1, c1);
      }
      *(f32x4*)(ba + (size_t)(r0 + fr) * 16 + 4 * fq) = c0;
      *(f32x4*)(ba + (size_t)(r0 + 16 + fr) * 16 + 4 * fq) = c1;
    }
  }
}

DI void phase_gdn_prep(const Params& p, const Sub& s, char* lds) {
  const bf16_t* qkv = (const bf16_t*)(p.ws + W_SLOT2);
  const float* ba = (const float*)(p.ws + W_BA);
  bf16_t* GW = (bf16_t*)(p.ws + W_GW); bf16_t* GU = (bf16_t*)(p.ws + W_GU); bf16_t* GQK = (bf16_t*)(p.ws + W_GQK);
  bf16_t* GQ = (bf16_t*)(p.ws + W_GQ); bf16_t* GKT = (bf16_t*)(p.ws + W_GKT); float* GGC = (float*)(p.ws + W_GGC);
  char* R0 = lds; char* R1 = lds + 16384; char* R2 = lds + 32768; char* R3 = lds + 49152;
  const int it_lo = s.samp ? 4096 : 0, it_n = s.samp ? 64 : 4096;
  for (int k_ = 0; k_ * s.vg < it_n; ++k_) {
    int it = k_ * s.vg + s.vb;
    if (k_ * s.vg + (s.vb & ~1) >= it_n) continue;
    if (it >= it_n) it = it_n - 1;
    it += it_lo;
    const int cid = it >> 2, hq = it & 3;
    f32x4 akk[4], aqk[4];
#pragma unroll
    for (int hvi = 0; hvi < 2; ++hvi) {
    const int hv = 2 * hq + hvi;
    const int tid = VTID, lane = tid & 63, wave = tid >> 6, fr = lane & 15, fq = lane >> 4;
    const bool samp = cid >= 1024;
    const int row0 = samp ? MP + (cid - 1024) * 16 : cid * 64;
    const int tv = samp ? 16 : 64;
    const bool first = samp ? false : ((cid & 127) == 0);
    const int sb = cid - 1024;
    float beta = 0.f, gg = 0.f;
    if (lane < tv) {
      const float braw = ba[(size_t)(row0 + lane) * 16 + hv], araw = ba[(size_t)(row0 + lane) * 16 + 8 + hv];
      beta = sigmoidf_(braw);
      const float xx = araw + p.gdn_dt_bias[hv];
      const float sp = xx > 20.f ? xx : log1pf(expf(xx));
      gg = -expf(p.gdn_a_log[hv]) * sp;
    }
    float gcum = gg;
#pragma unroll
    for (int o = 1; o < 64; o <<= 1) { const float t = __shfl_up(gcum, o); if (lane >= o) gcum += t; }
    if (wave == 0) {
      const float gl_ = __shfl(gcum, 63);
      float* ge = GGC + ((size_t)cid * 8 + hv) * 256;
      ge[lane] = __expf(gcum); ge[64 + lane] = __expf(gl_ - gcum);
      if (lane == 0) ge[128] = __expf(gl_);
    }
    const int ln = lane;
    const bool hist_ok = !samp && !first;
#pragma unroll
    for (int seg = 0; seg < 3; ++seg) {
      if (seg < 2 && hvi == 1) continue;
      const int cb = seg == 0 ? hq * 128 : (seg == 1 ? 512 + hq * 128 : 1024 + hv * 128);
      const int ch = cb + 2 * ln;
      const float2 w0 = *(const float2*)(p.gdn_conv_w + 0 * 2048 + ch), w1 = *(const float2*)(p.gdn_conv_w + 1 * 2048 + ch);
      const float2 w2 = *(const float2*)(p.gdn_conv_w + 2 * 2048 + ch), w3 = *(const float2*)(p.gdn_conv_w + 3 * 2048 + ch);
      const int t0 = wave * 16, d0 = 2 * ln;
      float2 xs[19];
      {
        unsigned xu[19];
#pragma unroll
        for (int j = 0; j < 19; ++j) {
          const int trel = t0 - 3 + j;
          const bool ok = (trel < tv) && (trel >= 0 || hist_ok);
          xu[j] = *(const unsigned*)(qkv + (size_t)(ok ? row0 + trel : row0) * 2048 + ch);
        }
#pragma unroll
        for (int j = 0; j < 19; ++j) {
          const int trel = t0 - 3 + j;
          const bool ok = (trel < tv) && (trel >= 0 || hist_ok);
          xs[j].x = ok ? __uint_as_float(xu[j] << 16) : 0.f; xs[j].y = ok ? __uint_as_float(xu[j] & 0xffff0000u) : 0.f;
        }
        if (samp && wave == 0) {
#pragma unroll
          for (int j = 0; j < 3; ++j) xs[j] = *(const float2*)(p.st_conv + ((size_t)sb * 3 + j) * 2048 + ch);
        }
      }
      unsigned tp0[8], tp1[8];
      float a0v[16], a1v[16], ssv[16];
#pragma unroll
      for (int tt = 0; tt < 16; ++tt) {
        a0v[tt] = siluf_(w0.x * xs[tt].x + w1.x * xs[tt + 1].x + w2.x * xs[tt + 2].x + w3.x * xs[tt + 3].x);
        a1v[tt] = siluf_(w0.y * xs[tt].y + w1.y * xs[tt + 1].y + w2.y * xs[tt + 2].y + w3.y * xs[tt + 3].y);
        ssv[tt] = a0v[tt] * a0v[tt] + a1v[tt] * a1v[tt];
      }
      if (seg < 2) {
#pragma unroll
        for (int tt = 0; tt < 16; ++tt) ssv[tt] = row16_sum(ssv[tt]);
#pragma unroll
        for (int o = 16; o <= 32; o <<= 1) {
#pragma unroll
          for (int tt = 0; tt < 16; ++tt) ssv[tt] += __shfl_xor(ssv[tt], o);
        }
      }
#pragma unroll
      for (int tt = 0; tt < 16; ++tt) {
        const int t = t0 + tt;
        float a0 = a0v[tt], a1 = a1v[tt];
        if (seg < 2) {
          float rs = rsqrtf(ssv[tt] + EPS);
          if (seg == 0) rs *= 0.08838834764831845f;
          a0 *= rs; a1 *= rs;
        }
        if (t >= tv) { a0 = 0.f; a1 = 0.f; }
        if (seg == 0) {
          *(unsigned*)(R2 + t * 256 + (((d0 >> 3) ^ (t & 7)) << 4) + (d0 & 7) * 2) = pack2(a0, a1);
          *(unsigned*)(GQ + (((size_t)cid * 4 + hq) * 64 + t) * 128 + kperm(d0)) = pack2(a0, a1);
        } else {
          if (seg == 1) *(unsigned*)(R0 + t * 256 + (((d0 >> 3) ^ (t & 7)) << 4) + (d0 & 7) * 2) = pack2(a0, a1);
          a0v[tt] = a0; a1v[tt] = a1;
        }
      }
      if (seg >= 1) {
#pragma unroll
        for (int q = 0; q < 8; ++q) { tp0[q] = pack2(a0v[2 * q], a0v[2 * q + 1]); tp1[q] = pack2(a1v[2 * q], a1v[2 * q + 1]); }
      }
      if (seg >= 1) {
        char* dst = seg == 1 ? R1 : R3;
#pragma unroll
        for (int h = 0; h < 2; ++h) {
          const int chk = 2 * wave + h;
          uint4 v0, v1;
          v0.x = tp0[4 * h]; v0.y = tp0[4 * h + 1]; v0.z = tp0[4 * h + 2]; v0.w = tp0[4 * h + 3];
          v1.x = tp1[4 * h]; v1.y = tp1[4 * h + 1]; v1.z = tp1[4 * h + 2]; v1.w = tp1[4 * h + 3];
          *(uint4*)(dst + d0 * 128 + ((chk ^ (d0 & 7)) << 4)) = v0;
          *(uint4*)(dst + (d0 + 1) * 128 + ((chk ^ ((d0 + 1) & 7)) << 4)) = v1;
        }
      }
    }
    lds_barrier();
    if (hvi == 0) {
#pragma unroll
    for (int n = 0; n < 4; ++n) { akk[n] = (f32x4){0.f, 0.f, 0.f, 0.f}; aqk[n] = (f32x4){0.f, 0.f, 0.f, 0.f}; }
#pragma unroll
    for (int ks = 0; ks < 4; ++ks) {
      const bf16x8 ak = ldfrag(R0, 256, wave * 16 + fr, ks * 4 + fq), aq = ldfrag(R2, 256, wave * 16 + fr, ks * 4 + fq);
#pragma unroll
      for (int n = 0; n < 4; ++n) {
        const bf16x8 bk = ldfrag(R0, 256, n * 16 + fr, ks * 4 + fq);
        akk[n] = MFMA16(ak, bk, akk[n]); aqk[n] = MFMA16(aq, bk, aqk[n]);
      }
    }
    }
    lds_barrier();
    {
      float* Mx = (float*)R0;
#pragma unroll
      for (int n = 0; n < 4; ++n) {
        const int jj = n * 16 + fr;
        const float gj = __shfl(gcum, jj);
#pragma unroll
        for (int j = 0; j < 4; ++j) {
          const int i = wave * 16 + 4 * fq + j;
          const float gi = __shfl(gcum, i), bi = __shfl(beta, i);
          const float dec = (i >= jj) ? __expf(gi - gj) : 0.f;
          Mx[i * 64 + jj] = (i > jj) ? bi * akk[n][j] * dec : 0.f;
          GQK[(((size_t)cid * 8 + hv) * 64 + i) * 64 + kperm(jj)] = f2bf(aqk[n][j] * dec);
        }
      }
    }
    lds_barrier();
    if ((hv & 1) == 0) {
#pragma unroll
      for (int q = 0; q < 4; ++q) {
        const int Lc = tid + q * 256, row = Lc >> 3, ch = Lc & 7;
        { const uint4 v_ = *(const uint4*)(R1 + row * 128 + ((ch ^ (row & 7)) << 4)); bf16_t* d_ = GKT + (((size_t)cid * 4 + hq) * 128 + row) * 64;
          uint2 lo_, hi_; lo_.x = v_.x; lo_.y = v_.y; hi_.x = v_.z; hi_.y = v_.w;
          *(uint2*)(d_ + kperm(ch * 8)) = lo_; *(uint2*)(d_ + kperm(ch * 8 + 4)) = hi_; }
      }
    }
    {
      const float* Mx = (const float*)R0;
      bf16_t* XT = (bf16_t*)R2;
      bf16_t* Xr = (bf16_t*)(R2 + 8192);
      {
        const int a = wave, c = lane & 15;
        float x[16];
#pragma unroll
        for (int i = 0; i < 16; ++i) {
          const float mrow = Mx[(16 * a + i) * 64 + 16 * a + c];
          float s0 = (c == i) ? 1.f : 0.f, s1 = 0.f;
#pragma unroll
          for (int j = 0; j < i; ++j) {
            const float mv = __int_as_float(__builtin_amdgcn_readlane(__float_as_int(mrow), j));
            if (j & 1) s1 -= mv * x[j]; else s0 -= mv * x[j];
          }
          x[i] = s0 + s1;
        }
        if (lane < 16) {
#pragma unroll
          for (int i = 0; i < 16; ++i) Xr[(16 * a + i) * 64 + 16 * a + c] = f2bf(x[i]);
          uint4 v0, v1;
          v0.x = pack2(x[0], x[1]); v0.y = pack2(x[2], x[3]); v0.z = pack2(x[4], x[5]); v0.w = pack2(x[6], x[7]);
          v1.x = pack2(x[8], x[9]); v1.y = pack2(x[10], x[11]); v1.z = pack2(x[12], x[13]); v1.w = pack2(x[14], x[15]);
          *(uint4*)(XT + (16 * a + c) * 64 + 16 * a) = v0;
          *(uint4*)(XT + (16 * a + c) * 64 + 16 * a + 8) = v1;
        }
      }
      lds_barrier();
      typedef unsigned u32x4 __attribute__((ext_vector_type(4)));
#pragma unroll
      for (int a = 1; a < 4; ++a) {
        if (wave < a) {
          const int b = wave, len = 16 * (a - b);
          f32x4 T = (f32x4){0.f, 0.f, 0.f, 0.f};
#pragma unroll
          for (int kk = 0; kk < 2; ++kk) {
            if (kk * 32 < len) {
              const int k0 = kk * 32 + fq * 8;
              u32x4 av = (u32x4){0u, 0u, 0u, 0u}, bv = (u32x4){0u, 0u, 0u, 0u};
              if (k0 < len) {
                const float* mp = Mx + (16 * a + fr) * 64 + 16 * b + k0;
                const float4 m0 = *(const float4*)mp, m1 = *(const float4*)(mp + 4);
                av[0] = pack2(m0.x, m0.y); av[1] = pack2(m0.z, m0.w); av[2] = pack2(m1.x, m1.y); av[3] = pack2(m1.z, m1.w);
                bv = *(const u32x4*)(XT + (16 * b + fr) * 64 + 16 * b + k0);
              }
              T = MFMA16(__builtin_bit_cast(bf16x8, av), __builtin_bit_cast(bf16x8, bv), T);
            }
          }
          const uint2 dv = *(const uint2*)(Xr + (16 * a + fr) * 64 + 16 * a + 4 * fq);
          u32x4 ad = (u32x4){dv.x, dv.y, 0u, 0u}, bt = (u32x4){pack2(T[0], T[1]), pack2(T[2], T[3]), 0u, 0u};
          const f32x4 Xab = MFMA16(__builtin_bit_cast(bf16x8, ad), __builtin_bit_cast(bf16x8, bt), ((f32x4){0.f, 0.f, 0.f, 0.f}));
          uint2 xo; xo.x = pack2(-Xab[0], -Xab[1]); xo.y = pack2(-Xab[2], -Xab[3]);
          *(uint2*)(XT + (16 * b + fr) * 64 + 16 * a + 4 * fq) = xo;
#pragma unroll
          for (int j = 0; j < 4; ++j) Xr[(16 * a + 4 * fq + j) * 64 + 16 * b + fr] = f2bf(-Xab[j]);
        }
        lds_barrier();
      }
      {
        const int i = tid >> 2, cg = tid & 3;
        const uint4 r0 = *(const uint4*)(Xr + i * 64 + cg * 16), r1 = *(const uint4*)(Xr + i * 64 + cg * 16 + 8);
        const unsigned rw[8] = {r0.x, r0.y, r0.z, r0.w, r1.x, r1.y, r1.z, r1.w};
        float aw[16], au[16];
#pragma unroll
        for (int q = 0; q < 16; ++q) {
          const int j = cg * 16 + q;
          const float bj = __shfl(beta, j), gj = __shfl(gcum, j);
          const float xraw = (q & 1) ? __uint_as_float(rw[q >> 1] & 0xffff0000u) : __uint_as_float(rw[q >> 1] << 16);
          const float xx = ((i >> 4) >= cg) ? xraw : 0.f;
          au[q] = xx * bj; aw[q] = xx * bj * __expf(gj);
        }
        lds_barrier();
#pragma unroll
        for (int h = 0; h < 2; ++h) {
          uint4 vw, vu;
          vw.x = pack2(aw[8 * h], aw[8 * h + 1]); vw.y = pack2(aw[8 * h + 2], aw[8 * h + 3]); vw.z = pack2(aw[8 * h + 4], aw[8 * h + 5]); vw.w = pack2(aw[8 * h + 6], aw[8 * h + 7]);
          vu.x = pack2(au[8 * h], au[8 * h + 1]); vu.y = pack2(au[8 * h + 2], au[8 * h + 3]); vu.z = pack2(au[8 * h + 4], au[8 * h + 5]); vu.w = pack2(au[8 * h + 6], au[8 * h + 7]);
          const int o = i * 128 + (((2 * cg + h) ^ (i & 7)) << 4);
          *(uint4*)(R2 + o) = vw; *(uint4*)(R2 + 8192 + o) = vu;
        }
      }
    }
    lds_barrier();
    {
      const bf16x8 aw0 = ldfrag(R2, 128, wave * 16 + fr, fq), aw1 = ldfrag(R2, 128, wave * 16 + fr, 4 + fq);
      const bf16x8 au0 = ldfrag(R2 + 8192, 128, wave * 16 + fr, fq), au1 = ldfrag(R2 + 8192, 128, wave * 16 + fr, 4 + fq);
      const size_t ob = (((size_t)cid * 8 + hv) * 64 + wave * 16 + fr) * 128;
#pragma unroll
      for (int n = 0; n < 8; ++n) {
        f32x4 cw = (f32x4){0.f, 0.f, 0.f, 0.f}, cu = (f32x4){0.f, 0.f, 0.f, 0.f};
        cw = MFMA16(ldfrag(R1, 128, n * 16 + fr, fq), aw0, cw); cw = MFMA16(ldfrag(R1, 128, n * 16 + fr, 4 + fq), aw1, cw);
        cu = MFMA16(au0, ldfrag(R3, 128, n * 16 + fr, fq), cu); cu = MFMA16(au1, ldfrag(R3, 128, n * 16 + fr, 4 + fq), cu);
        st_bf4(GW + ob + kperm(n * 16 + 4 * fq), cw[0], cw[1], cw[2], cw[3]);
        st_bf4(GU + ((size_t)cid * 8 + hv) * 8192 + ((n * 4 + wave) * 64 + lane) * 4, cu[0], cu[1], cu[2], cu[3]);
      }
    }
    lds_barrier();
    }
  }
}

DI void phase_gdn_seq(const Params& p, const Sub& s, char* lds_all) {
  const int tid = VTID, lane = tid & 63, wave = tid >> 6, fr = lane & 15, fq = lane >> 4;
  const bf16_t* GW = (const bf16_t*)(p.ws + W_GW); const bf16_t* GU = (const bf16_t*)(p.ws + W_GU); const bf16_t* GQK = (const bf16_t*)(p.ws + W_GQK);
  const bf16_t* GQ = (const bf16_t*)(p.ws + W_GQ); const bf16_t* GKT = (const bf16_t*)(p.ws + W_GKT); const float* GGC = (const float*)(p.ws + W_GGC);
  bf16_t* O = (bf16_t*)(p.ws + W_SLOT0);
  for (int rb = blockIdx.x; rb < 256; rb += gridDim.x) {
    if ((rb >= 128) != s.samp) continue;
    const int hh = otid() >> 8;
    const bool act = rb >= 128 || hh == 0;
    const int it = rb < 128 ? rb : 128 + (rb - 128) * 2 + hh;
    const bool samp = it >= 128;
    int b, hv, half, nsteps, cid0;
    if (!samp) { b = it >> 4; hv = (it >> 1) & 7; half = it & 1; nsteps = 128; cid0 = b * 128; }
    else { const int s = it - 128; b = s >> 4; hv = (s >> 1) & 7; half = s & 1; nsteps = 1; cid0 = 1024 + b; }
    const int hq = hv >> 1, dv0 = half * 64 + wave * 16;
    const int tv = samp ? 16 : 64;
    f32x4 S[8];
#pragma unroll
    for (int m = 0; m < 8; ++m) {
      S[m] = (f32x4){0.f, 0.f, 0.f, 0.f};
      if (samp && act) {
#pragma unroll
        for (int j = 0; j < 4; ++j) S[m][j] = p.st_gdn[(((size_t)b * 8 + hv) * 128 + m * 16 + 4 * fq + j) * 128 + dv0 + fr];
      }
    }
#define DMA_GT(cid_, slot_) do { if (wave == 0) __builtin_amdgcn_global_load_lds((const unsigned*)(GGC + ((size_t)(cid_) * 8 + hv) * 256 + lane * 4), \
      (LAS unsigned*)((LAS char*)lds_all + 131072 + (slot_) * 1024 + lane * 16), 16, 0, 0); } while (0)
    char* lbase = rb < 128 ? lds_all : lds_all + ((otid() >> 8) << 16);
    LAS char* l3 = (LAS char*)lbase;
#define DMA16(gp, loff) __builtin_amdgcn_global_load_lds((const unsigned*)(gp), (LAS unsigned*)(l3 + boff__ + (loff)), 16, 0, 0)
#define DMA_WU(cid_, bo_) do { const int cid__ = (cid_); const int boff__ = (bo_); \
      const bf16_t* sw = GW + ((size_t)cid__ * 8 + hv) * 8192; \
      const bf16_t* su = GU + ((size_t)cid__ * 8 + hv) * 8192 + half * 4096; \
      _Pragma("unroll") for (int i = 0; i < 4; ++i) { const int id = tid + i * 256, r = id >> 4, c = (id & 15) ^ (r & 7); DMA16(sw + r * 128 + c * 8, id * 16); } \
      _Pragma("unroll") for (int i = 0; i < 2; ++i) { const int id = tid + i * 256, r = id >> 3, c = id & 7; DMA16(su + id * 8, 57344 + id * 16); } } while (0)
#define DMA_QK(cid_, bo_) do { const int cid__ = (cid_); const int boff__ = (bo_); \
      const bf16_t* sq = GQ + ((size_t)cid__ * 4 + hq) * 8192; \
      const bf16_t* sk = GKT + ((size_t)cid__ * 4 + hq) * 8192; \
      const bf16_t* sqk = GQK + ((size_t)cid__ * 8 + hv) * 4096; \
      _Pragma("unroll") for (int i = 0; i < 4; ++i) { const int id = tid + i * 256, r = id >> 4, c = (id & 15) ^ (r & 7); DMA16(sq + r * 128 + c * 8, 16384 + id * 16); } \
      _Pragma("unroll") for (int i = 0; i < 4; ++i) { const int id = tid + i * 256, r = id >> 3, c = (id & 7) ^ (r & 7); DMA16(sk + r * 64 + c * 8, 32768 + id * 16); } \
      _Pragma("unroll") for (int i = 0; i < 2; ++i) { const int id = tid + i * 256, r = id >> 3, c = (id & 7) ^ (r & 7); DMA16(sqk + r * 64 + c * 8, 49152 + id * 16); } } while (0)
    const bool ldr = rb < 128 ? (hh == 1) : true;
    if (ldr) { DMA_WU(cid0, 0); DMA_QK(cid0, 0); DMA_GT(cid0, rb < 128 ? 0 : hh); }
    asm volatile("s_waitcnt vmcnt(0)" ::: "memory");
    __syncthreads();
    for (int n = 0; n < nsteps; ++n) {
      const int tid = VTID, lane = tid & 63, wave = tid >> 6, fr = lane & 15, fq = lane >> 4;
      const int dv0 = half * 64 + wave * 16;
      const int row0 = samp ? MP + b * 16 : (cid0 + n) * 64;
      const int bcur = (rb < 128) ? ((n & 1) << 16) : 0, bnxt = bcur ^ 65536;
      const char* Lw = lbase + bcur; const char* Lq = Lw + 16384; const char* Lk = Lw + 32768; const char* Lqk = Lw + 49152; const char* Lu = Lw + 57344;
      if (n + 1 < nsteps) {
        if (ldr) { DMA_WU(cid0 + n + 1, bnxt); DMA_QK(cid0 + n + 1, bnxt); DMA_GT(cid0 + n + 1, (n + 1) & 1); }
      }
      bf16x8 Sb[4];
#pragma unroll
      for (int c = 0; c < 4; ++c) Sb[c] = mkfrag(S[2 * c], S[2 * c + 1]);
      const float* Lt = (const float*)(lds_all + 131072 + ((rb < 128) ? (n & 1) : hh) * 1024);
      bf16x8 VN[2], VD[2];
      float eg[4][4];
#pragma unroll
      for (int c = 0; c < 2; ++c) { VN[c] = Sb[0]; VD[c] = Sb[0]; }
#pragma unroll
      for (int i = 0; i < 4; ++i)
#pragma unroll
        for (int j = 0; j < 4; ++j) eg[i][j] = 0.f;
      if (act) {
        f32x4 vn[4], vd[4], wsv[4];
        bf16x8 aw[4][4];
        float uu[4][4], gtv[4][4];
#pragma unroll
        for (int i = 0; i < 4; ++i)
#pragma unroll
          for (int c = 0; c < 4; ++c) aw[i][c] = ldfrag(Lw, 256, i * 16 + fr, 4 * c + fq);
#pragma unroll
        for (int i = 0; i < 4; ++i) {
          const uint2 u2 = *(const uint2*)(Lu + ((wave * 4 + i) * 64 + lane) * 8);
          uu[i][0] = __uint_as_float(u2.x << 16); uu[i][1] = __uint_as_float(u2.x & 0xffff0000u);
          uu[i][2] = __uint_as_float(u2.y << 16); uu[i][3] = __uint_as_float(u2.y & 0xffff0000u);
          { const float4 e4 = *(const float4*)(Lt + 64 + i * 16 + 4 * fq), g4 = *(const float4*)(Lt + i * 16 + 4 * fq);
            gtv[i][0] = e4.x; gtv[i][1] = e4.y; gtv[i][2] = e4.z; gtv[i][3] = e4.w;
            eg[i][0] = g4.x; eg[i][1] = g4.y; eg[i][2] = g4.z; eg[i][3] = g4.w; }
        }
#pragma unroll
        for (int i = 0; i < 4; ++i) wsv[i] = (f32x4){0.f, 0.f, 0.f, 0.f};
#pragma unroll
        for (int c = 0; c < 4; ++c)
#pragma unroll
          for (int i = 0; i < 4; ++i) wsv[i] = MFMA16(aw[i][c], Sb[c], wsv[i]);
#pragma unroll
        for (int i = 0; i < 4; ++i) {
          const f32x4 ws_ = wsv[i];
#pragma unroll
          for (int j = 0; j < 4; ++j) {
            const float u = uu[i][j];
            vn[i][j] = u - ws_[j];
            vd[i][j] = vn[i][j] * gtv[i][j];
          }
        }
#pragma unroll
        for (int c = 0; c < 2; ++c) { VN[c] = mkfrag(vn[2 * c], vn[2 * c + 1]); VD[c] = mkfrag(vd[2 * c], vd[2 * c + 1]); }
      }
      if (act) {
#pragma unroll
      for (int ih = 0; ih < 2; ++ih) {
        bf16x8 aq[2][4], aqk[2][2];
        f32x4 qsv[2];
#pragma unroll
        for (int ii = 0; ii < 2; ++ii) {
          const int i = ih * 2 + ii;
#pragma unroll
          for (int c = 0; c < 4; ++c) aq[ii][c] = ldfrag(Lq, 256, i * 16 + fr, 4 * c + fq);
#pragma unroll
          for (int c = 0; c < 2; ++c) aqk[ii][c] = ldfrag(Lqk, 128, i * 16 + fr, 4 * c + fq);
          qsv[ii] = (f32x4){0.f, 0.f, 0.f, 0.f};
        }
#pragma unroll
        for (int c = 0; c < 4; ++c)
#pragma unroll
          for (int ii = 0; ii < 2; ++ii) qsv[ii] = MFMA16(aq[ii][c], Sb[c], qsv[ii]);
#pragma unroll
        for (int ii = 0; ii < 2; ++ii)
#pragma unroll
          for (int j = 0; j < 4; ++j) qsv[ii][j] *= eg[ih * 2 + ii][j];
#pragma unroll
        for (int c = 0; c < 2; ++c)
#pragma unroll
          for (int ii = 0; ii < 2; ++ii) qsv[ii] = MFMA16(aqk[ii][c], VN[c], qsv[ii]);
#pragma unroll
        for (int ii = 0; ii < 2; ++ii)
#pragma unroll
          for (int j = 0; j < 4; ++j) {
            const int t = (ih * 2 + ii) * 16 + 4 * fq + j;
            if (t < tv) O[(size_t)(row0 + t) * D + hv * 128 + dv0 + fr] = f2bf(qsv[ii][j]);
          }
      }
      const float dec = Lt[128];
      {
        bf16x8 ak[8][2];
#pragma unroll
        for (int m = 0; m < 8; ++m) {
#pragma unroll
          for (int c = 0; c < 2; ++c) ak[m][c] = ldfrag(Lk, 128, m * 16 + fr, 4 * c + fq);
          S[m] = S[m] * dec;
        }
#pragma unroll
        for (int c = 0; c < 2; ++c)
#pragma unroll
          for (int m = 0; m < 8; ++m) S[m] = MFMA16(ak[m][c], VD[c], S[m]);
      }
      }
      asm volatile("s_waitcnt vmcnt(0)" ::: "memory");
      __syncthreads();
    }
    float* so = p.out + (samp ? O_GDN_S : O_GDN_P) + ((size_t)b * 8 + hv) * 16384;
    if (act) {
#pragma unroll
    for (int m = 0; m < 8; ++m)
#pragma unroll
      for (int j = 0; j < 4; ++j) so[(m * 16 + 4 * fq + j) * 128 + dv0 + fr] = S[m][j];
    }
  }
}

DI void phase_onorm(const Params& p, const Sub& s) {
  const int lane = VTID & 63, wave = VTID >> 6;
  const bf16_t* O = (const bf16_t*)(p.ws + W_SLOT0);
  const bf16_t* z1 = (const bf16_t*)(p.ws + W_SLOT1);
  bf16_t* on = (bf16_t*)(p.ws + W_SLOT2);
  const int stride = s.vg * 4, rhi = s.samp ? M : MP;
  float gpv[16];
#pragma unroll
  for (int i = 0; i < 16; ++i) gpv[i] = p.gdn_norm_g[(lane & 7) * 16 + i];
  for (int r = (s.samp ? MP : 0) + s.vb * 4 + wave; r < rhi; r += 2 * stride) {
    const bool two = r + stride < rhi;
    const int rr[2] = {r, two ? r + stride : r};
    float v[2][16], zz[2][16];
#pragma unroll
    for (int q = 0; q < 2; ++q) {
      const size_t o = (size_t)rr[q] * D + lane * 16;
#pragma unroll
      for (int i = 0; i < 4; ++i) { ld_bf4(O + o + i * 4, v[q][4 * i], v[q][4 * i + 1], v[q][4 * i + 2], v[q][4 * i + 3]); ld_bf4(z1 + o + i * 4, zz[q][4 * i], zz[q][4 * i + 1], zz[q][4 * i + 2], zz[q][4 * i + 3]); }
    }
#pragma unroll
    for (int q = 0; q < 2; ++q) {
      float ss = 0.f;
#pragma unroll
      for (int i = 0; i < 16; ++i) ss += v[q][i] * v[q][i];
      ss += __int_as_float(__builtin_amdgcn_update_dpp(0, __float_as_int(ss), 0xB1, 0xF, 0xF, true));
      ss += __int_as_float(__builtin_amdgcn_update_dpp(0, __float_as_int(ss), 0x4E, 0xF, 0xF, true));
      ss += __int_as_float(__builtin_amdgcn_update_dpp(0, __float_as_int(ss), 0x141, 0xF, 0xF, true));
      const float rs = rsqrtf(ss * (1.0f / 128.f) + EPS);
      if (q == 0 || two) {
        const size_t o = (size_t)rr[q] * D + lane * 16;
        float w[16];
#pragma unroll
        for (int i = 0; i < 16; ++i) w[i] = v[q][i] * rs * gpv[i] * siluf_(zz[q][i]);
#pragma unroll
        for (int i = 0; i < 4; ++i) st_bf4(on + o + i * 4, w[4 * i], w[4 * i + 1], w[4 * i + 2], w[4 * i + 3]);
      }
    }
  }
}

DI void phase_final(const Params& p, const Sub& s) {
  const int lane = VTID & 63, wave = VTID >> 6;
  const int stride = s.vg * 4, rhi = s.samp ? M : MP;
  for (int r = (s.samp ? MP : 0) + s.vb * 4 + wave; r < rhi; r += 2 * stride) {
    const int rr[2] = {r, (r + stride < rhi) ? r + stride : r};
    const bool two = r + stride < rhi;
    float4 v[2][4], g4[4];
#pragma unroll
    for (int q = 0; q < 2; ++q) {
      const bf16_t* srcb = (const bf16_t*)(p.ws + W_SLOT3) + (size_t)rr[q] * D;
#pragma unroll
      for (int i = 0; i < 4; ++i) ld_bf4(srcb + i * 256 + lane * 4, v[q][i].x, v[q][i].y, v[q][i].z, v[q][i].w);
    }
#pragma unroll
    for (int i = 0; i < 4; ++i) g4[i] = *(const float4*)(p.final_g + i * 256 + lane * 4);
#pragma unroll
    for (int q = 0; q < 2; ++q) {
      float ss = 0.f;
#pragma unroll
      for (int i = 0; i < 4; ++i) ss += v[q][i].x * v[q][i].x + v[q][i].y * v[q][i].y + v[q][i].z * v[q][i].z + v[q][i].w * v[q][i].w;
      ss = wave_sum(ss);
      const float rs = rsqrtf(ss * (1.0f / D) + EPS);
      if (q == 0 || two) {
        float* dstp = p.out + (size_t)rr[q] * D;
#pragma unroll
        for (int i = 0; i < 4; ++i) {
          float4 o; o.x = v[q][i].x * rs * g4[i].x; o.y = v[q][i].y * rs * g4[i].y; o.z = v[q][i].z * rs * g4[i].z; o.w = v[q][i].w * rs * g4[i].w;
          stnt4(dstp + i * 256 + lane * 4, o);
        }
      }
    }
  }
}


#define XB_TMO      128
#define XB_XCNT(j)  (256  + 64 * (j))
#define XB_XSUB(j)  (1280 + 64 * (j))
#define XB_XGEN(j)  (2304 + 64 * (j))
#define XB_TOP      3328
#define XB_TOPGEN   3392
#define XCD_BAR_WORDS 3456
#define XB_SUB 3456
#define XB_SPIN_CAP (1u << 18)
DI unsigned xb_ld(unsigned* p) { return __hip_atomic_load(p, __ATOMIC_RELAXED, __HIP_MEMORY_SCOPE_AGENT); }
DI unsigned xb_add(unsigned* p, unsigned v) { return __hip_atomic_fetch_add(p, v, __ATOMIC_RELAXED, __HIP_MEMORY_SCOPE_AGENT); }
DI unsigned xb_xcc_id() { return (unsigned)__builtin_amdgcn_s_getreg((3 << 11) | 20) & 0xFu; }
#define XB_SPIN(cond, bar) do { unsigned _sp = 0; while (cond) { __builtin_amdgcn_s_sleep(1); \
    if ((++_sp & 255u) == 0u) { if (xb_ld(&(bar)[XB_TMO])) break; if (_sp > XB_SPIN_CAP) { atomicAdd(&(bar)[XB_TMO], 1u); break; } } } } while (0)
struct XcdBarrier { unsigned* bar; unsigned x; volatile LAS unsigned* st; };
DI XcdBarrier xcd_barrier_post(unsigned* bar, volatile LAS unsigned* st) {
  XcdBarrier b; b.bar = bar; b.x = xb_xcc_id(); b.st = st;
  if (threadIdx.x == 0) (void)xb_add(&bar[XB_XCNT(b.x)], 1u);
  return b;
}
DI void xcd_barrier_complete(unsigned* bar, unsigned x, unsigned& nloc, unsigned& nx) {
  const unsigned G = gridDim.x * gridDim.y * gridDim.z;
  unsigned sum, cnt, mine, sp = 0u;
  for (;;) {
    sum = 0u; cnt = 0u; mine = 0u;
#pragma unroll
    for (unsigned j = 0; j < 16; ++j) { const unsigned c = xb_ld(&bar[XB_XCNT(j)]); sum += c; cnt += (c > 0u) ? 1u : 0u; mine = (j == x) ? c : mine; }
    if (sum == G) break;
    __builtin_amdgcn_s_sleep(1);
    if ((++sp & 255u) == 0u) { if (xb_ld(&bar[XB_TMO])) break; if (sp > XB_SPIN_CAP) { atomicAdd(&bar[XB_TMO], 1u); break; } }
  }
  nloc = mine > 0u ? mine : 1u; nx = cnt > 0u ? cnt : 1u;
}
DI void xcd_barrier(const XcdBarrier& b) {
  asm volatile("s_waitcnt vmcnt(0)" ::: "memory");
  __syncthreads();
  if (threadIdx.x == 0) {
    unsigned* bar = b.bar;
    __builtin_amdgcn_s_waitcnt(0);
    unsigned nloc = b.st[0], nx = b.st[1];
    if (nloc == 0u) { xcd_barrier_complete(bar, b.x, nloc, nx); b.st[0] = nloc; b.st[1] = nx; }
    const unsigned old = xb_add(&bar[XB_XSUB(b.x)], 1u);
    const unsigned gen = old / nloc;
    if (old + 1u == (gen + 1u) * nloc) {
      __builtin_amdgcn_fence(__ATOMIC_RELEASE, "agent");
      asm volatile("s_waitcnt vmcnt(0)" ::: "memory");
      const unsigned og = xb_add(&bar[XB_TOP], 1u);
      const unsigned tg = og / nx;
      if (og + 1u == (tg + 1u) * nx) xb_add(&bar[XB_TOPGEN], 1u);
      else XB_SPIN(xb_ld(&bar[XB_TOPGEN]) == tg, bar);
      __builtin_amdgcn_fence(__ATOMIC_ACQUIRE, "agent");
      xb_add(&bar[XB_XGEN(b.x)], 1u);
      asm volatile("s_waitcnt vmcnt(0)" ::: "memory");
    } else {
      XB_SPIN(xb_ld(&bar[XB_XGEN(b.x)]) == gen, bar);
      __builtin_amdgcn_fence(__ATOMIC_ACQUIRE, "agent");
      asm volatile("s_waitcnt vmcnt(0)" ::: "memory");
    }
  }
  __syncthreads();
}

#define AS4 __attribute__((address_space(4)))
DI void load_params(Params& q) {
#if defined(__HIP_DEVICE_COMPILE__)
  int off = 0; asm volatile("" : "+s"(off));
  q = *(const Params AS4*)((const char AS4*)__builtin_amdgcn_kernarg_segment_ptr() + off);
#endif
}
DI void sub_barrier(unsigned* bar, unsigned target) {
  asm volatile("s_waitcnt vmcnt(0)" ::: "memory");
  __syncthreads();
  if (threadIdx.x == 0) {
    __builtin_amdgcn_fence(__ATOMIC_RELEASE, "agent");
    asm volatile("s_waitcnt vmcnt(0)" ::: "memory");
    xb_add(&bar[XB_SUB], 1u);
    XB_SPIN(xb_ld(&bar[XB_SUB]) < target, bar);
    __builtin_amdgcn_fence(__ATOMIC_ACQUIRE, "agent");
    asm volatile("s_waitcnt vmcnt(0)" ::: "memory");
  }
  __syncthreads();
}

__global__ void __launch_bounds__(512, 1) fwd_megakernel(Params p) {
  __shared__ __attribute__((aligned(16))) char lds_all[LDS_BYTES];
#define lds (lds_all + ((otid() >> 8) << 16))
  cg::grid_group grid = cg::this_grid();
  __shared__ uint4 xb_words;
  if (threadIdx.x == 0) xb_words = make_uint4(0u, 0u, 0u, 0u);
  __syncthreads();
  { Params q; load_params(q); (void)xcd_barrier_post((unsigned*)(q.ws + W_BAR), (volatile LAS unsigned*)&xb_words); }
#define GSYNC() do { Params q_; load_params(q_); XcdBarrier b_; b_.bar = (unsigned*)(q_.ws + W_BAR); b_.x = xb_xcc_id(); b_.st = (volatile LAS unsigned*)&xb_words; xcd_barrier(b_); } while (0)
#define PSUB Sub{VBID, VGRID, false}
  if (gridDim.x > 65535u) grid.sync();
  for (int rep = 0; rep < REP_SETUP; ++rep) { { Params q; load_params(q); phase_setup(q, lds); } GSYNC(); }
  { Params q; load_params(q); phase_norm_mod(q, PSUB, 0, false, (bf16_t*)(q.ws + W_SLOT0)); phase_norm_mod(q, Sub{VBID, VGRID, true}, 0, false, (bf16_t*)(q.ws + W_SLOT0)); }
  GSYNC();
  for (int rep = 0; rep < REP_GEMM; ++rep) { { Params q; load_params(q); phase_g1(q, PSUB, lds_all); } GSYNC(); }
  for (int rep = 0; rep < REP_S5; ++rep) {
    { Params q; load_params(q); phase_s5_e(q, lds); }
    GSYNC();
    { Params q; load_params(q); phase_s5_scan(q); }
    GSYNC();
    { Params q; load_params(q); phase_s5_y(q, lds); }
    GSYNC();
  }
  for (int rep = 0; rep < REP_GEMM; ++rep) { { Params q; load_params(q); phase_g2(q, PSUB, lds_all); } GSYNC(); }
  for (int rep = 0; rep < REP_GEMM; ++rep) { { Params q; load_params(q); phase_gout(q, PSUB, lds_all, 0, (const bf16_t*)(q.ws + W_SLOT0), (const bf16_t*)(q.ws + W_S5OUT)); } GSYNC(); }
  { Params q; load_params(q); phase_norm_mod(q, PSUB, 1, true, (bf16_t*)(q.ws + W_SLOT0)); }
  GSYNC();
  for (int rep = 0; rep < REP_GEMM; ++rep) { { Params q; load_params(q); phase_g4(q, PSUB, lds_all); } GSYNC(); }
  for (int rep = 0; rep < REP_PREP; ++rep) { { Params q; load_params(q); phase_gdn_prep(q, PSUB, lds); } GSYNC(); }
  if (blockIdx.x < 128) {
    { Params q; load_params(q); phase_gdn_seq(q, Sub{0, 0, false}, lds_all); }
  } else {
    const int svb = (blockIdx.x - 128) * 2 + (otid() >> 8);
    unsigned tgt = 0;
#define SSUB Sub{svb, 256, true}
#define SSYNC() do { Params q_; load_params(q_); tgt += gridDim.x - 128; sub_barrier((unsigned*)(q_.ws + W_BAR), tgt); } while (0)
    { Params q; load_params(q); phase_g1(q, SSUB, lds_all); }
    SSYNC();
    { Params q; load_params(q); phase_s5_sample(q, SSUB); }
    SSYNC();
    { Params q; load_params(q); phase_g2(q, SSUB, lds_all); }
    SSYNC();
    { Params q; load_params(q); phase_gout(q, SSUB, lds_all, 0, (const bf16_t*)(q.ws + W_SLOT0), (const bf16_t*)(q.ws + W_S5OUT)); }
    SSYNC();
    { Params q; load_params(q); phase_norm_mod(q, SSUB, 1, true, (bf16_t*)(q.ws + W_SLOT0)); }
    SSYNC();
    { Params q; load_params(q); phase_g4(q, SSUB, lds_all); }
    SSYNC();
    { Params q; load_params(q); phase_gdn_prep(q, SSUB, lds); }
    SSYNC();
    { Params q; load_params(q); phase_gdn_seq(q, SSUB, lds_all); }
    SSYNC();
    { Params q; load_params(q); phase_onorm(q, SSUB); }
    SSYNC();
    { Params q; load_params(q); phase_gout(q, SSUB, lds_all, 1, (const bf16_t*)(q.ws + W_SLOT2), (const bf16_t*)(q.ws + W_GDNOUT)); }
  }
  GSYNC();
  { Params q; load_params(q); phase_onorm(q, PSUB); }
  GSYNC();
  { Params q; load_params(q); phase_gout(q, PSUB, lds_all, 1, (const bf16_t*)(q.ws + W_SLOT2), (const bf16_t*)(q.ws + W_GDNOUT)); }
  GSYNC();
  { Params q; load_params(q); phase_final(q, PSUB); phase_final(q, Sub{VBID, VGRID, true}); }
#undef lds
}

extern "C" void kernel_launch(void* const* d_in, const int* in_sizes, int n_in, void* d_out, int out_size, void* d_ws, size_t ws_size,
                              hipStream_t stream) {
  static int grid_blocks = 0;
  if (!grid_blocks) {
    int dev = 0, cus = 0, per_cu = 0;
    hipGetDevice(&dev);
    hipDeviceGetAttribute(&cus, hipDeviceAttributeMultiprocessorCount, dev);
    hipOccupancyMaxActiveBlocksPerMultiprocessor(&per_cu, fwd_megakernel, 512, 0);
    if (per_cu > 1) per_cu = 1;
    if (per_cu < 1) per_cu = 1;
    grid_blocks = cus * per_cu;
    grid_blocks &= ~7;
  }
  Params p{};
  const float** pp = (const float**)&p;
  for (int i = 0; i < 30; ++i) pp[i] = (const float*)d_in[i];
  p.out = (float*)d_out;
  p.ws = (char*)d_ws;
  hipMemsetAsync((char*)d_ws + W_BAR, 0, (XCD_BAR_WORDS + 64) * 4, stream);
  void* args[] = {&p};
  hipError_t e = hipLaunchCooperativeKernel((void*)fwd_megakernel, dim3(grid_blocks), dim3(512), args, 0, stream);
  if (e != hipSuccess) fprintf(stderr, "cooperative launch failed: %s (grid %d)\n", hipGetErrorString(e), grid_blocks);
}
```
